# Optimizing an MI355X kernel written in HIP

```python
import jax, jax.numpy as jnp
from jax import lax
import numpy as np

D_MODEL = 2048
BATCH = 4
SEQ = 4096
DEPTH = 2

N_MIXERS = 2
N_LAYERS_A = (DEPTH + 1) // 2
N_LAYERS_B = DEPTH // 2

H_A = 8
QK_W = D_MODEL // 2
V_W = D_MODEL
DQK = QK_W // H_A
DV = V_W // H_A
CHUNK = 128
IN_A = 2 * QK_W + 2 * V_W + 2 * H_A

D_RNN = D_MODEL
N_BLOCKS = 8
BLOCK_W = D_RNN // N_BLOCKS
CONV_W = 4
RG_C = 8.0

D_FF = 4 * D_MODEL

EPS = 1e-6

kernel_name = "hybrid_mlstm_rglru_adaln_trunk"


def rms_norm(x):
    xf = x.astype(jnp.float32)
    return (xf * lax.rsqrt(jnp.mean(xf * xf, axis=-1, keepdims=True) + EPS)).astype(x.dtype)


def ada_modulate(x, c, w, b):
    mod = jax.nn.silu(c) @ w + b
    shift, scale, gate = jnp.split(mod, 3, axis=-1)
    h = rms_norm(x) * (1.0 + scale[:, None, :]) + shift[:, None, :]
    return h, gate[:, None, :]


def mlstm_chunkwise(q, k, v, li, lf):
    B, H, S, _ = q.shape
    nc = S // CHUNK

    def chunks(t):
        return jnp.moveaxis(t.reshape(B, H, nc, CHUNK, *t.shape[3:]), 2, 0)

    tri = jnp.tril(jnp.ones((CHUNK, CHUNK), dtype=bool))

    def step(carry, xs):
        C, n, m = carry
        qc, kc, vc, lic, lfc = xs
        b = jnp.cumsum(lfc, axis=-1)
        d = b[..., :, None] - b[..., None, :] + lic[..., None, :]
        d = jnp.where(tri, d, -jnp.inf)
        inter = b + m[..., None]
        m_t = jnp.maximum(inter, jnp.max(d, axis=-1))
        w_inter = jnp.exp(inter - m_t)
        p = jnp.exp(d - m_t[..., None]) * jnp.einsum("bhtd,bhsd->bhts", qc, kc)
        num = (w_inter[..., None] * jnp.einsum("bhtd,bhde->bhte", qc, C)
               + jnp.einsum("bhts,bhse->bhte", p, vc))
        den = w_inter * jnp.einsum("bhtd,bhd->bht", qc, n) + jnp.sum(p, axis=-1)
        h = num / jnp.maximum(jnp.abs(den), jnp.exp(-m_t))[..., None]
        b_last = b[..., -1]
        g = b_last[..., None] - b + lic
        m_new = jnp.maximum(b_last + m, jnp.max(g, axis=-1))
        wk = jnp.exp(g - m_new[..., None])
        decay = jnp.exp(b_last + m - m_new)
        C_new = decay[..., None, None] * C + jnp.einsum("bhs,bhsd,bhse->bhde", wk, kc, vc)
        n_new = decay[..., None] * n + jnp.einsum("bhs,bhsd->bhd", wk, kc)
        return (C_new, n_new, m_new), h

    init = (jnp.zeros((B, H, DQK, DV), jnp.float32),
            jnp.zeros((B, H, DQK), jnp.float32),
            jnp.zeros((B, H), jnp.float32))
    _, hs = lax.scan(step, init, (chunks(q), chunks(k), chunks(v), chunks(li), chunks(lf)))
    return jnp.moveaxis(hs, 0, 2).reshape(B, H, S, DV)


def mlstm_mixer(h, w_in, b_gate, norm_g, w_out):
    B, S, _ = h.shape
    proj = h @ w_in
    q, k, v, o, ig, fg = jnp.split(
        proj, [QK_W, 2 * QK_W, 2 * QK_W + V_W, 2 * QK_W + 2 * V_W, 2 * QK_W + 2 * V_W + H_A], axis=-1)
    q = q.reshape(B, S, H_A, DQK).transpose(0, 2, 1, 3).astype(jnp.float32) * (DQK ** -0.5)
    k = k.reshape(B, S, H_A, DQK).transpose(0, 2, 1, 3).astype(jnp.float32)
    v = v.reshape(B, S, H_A, DV).transpose(0, 2, 1, 3).astype(jnp.float32)
    li = (ig.astype(jnp.float32) + b_gate[0].astype(jnp.float32)).transpose(0, 2, 1)
    lf = jax.nn.log_sigmoid(fg.astype(jnp.float32) + b_gate[1].astype(jnp.float32)).transpose(0, 2, 1)
    hh = mlstm_chunkwise(q, k, v, li, lf).transpose(0, 2, 1, 3)
    hh = hh * lax.rsqrt(jnp.mean(hh * hh, axis=-1, keepdims=True) + EPS)
    hh = hh.reshape(B, S, V_W) * norm_g.astype(jnp.float32)
    return (hh.astype(h.dtype) * jax.nn.sigmoid(o)) @ w_out


def _lin_combine(e1, e2):
    a1, b1 = e1
    a2, b2 = e2
    return a1 * a2, a2 * b1 + b2


def rglru_mixer(h, w_in, conv_w, conv_b, w_ra, b_ra, w_ri, b_ri, lam, w_out):
    B, S, _ = h.shape
    xb, gb = jnp.split(h @ w_in, 2, axis=-1)
    xb = lax.conv_general_dilated(
        xb, conv_w[:, None, :], window_strides=(1,), padding=[(CONV_W - 1, 0)],
        dimension_numbers=("NWC", "WIO", "NWC"), feature_group_count=D_RNN) + conv_b
    xf = xb.astype(jnp.float32)
    xblk = xf.reshape(B, S, N_BLOCKS, BLOCK_W)
    r = jax.nn.sigmoid(jnp.einsum("bsnc,ncd->bsnd", xblk, w_ra.astype(jnp.float32)).reshape(B, S, D_RNN)
                       + b_ra.astype(jnp.float32))
    i = jax.nn.sigmoid(jnp.einsum("bsnc,ncd->bsnd", xblk, w_ri.astype(jnp.float32)).reshape(B, S, D_RNN)
                       + b_ri.astype(jnp.float32))
    log_a = -RG_C * r * jax.nn.softplus(-lam.astype(jnp.float32))
    a = jnp.exp(log_a)
    u = jnp.sqrt(-jnp.expm1(2.0 * log_a)) * (i * xf)
    _, hs = lax.associative_scan(_lin_combine, (a, u), axis=1)
    y = hs.astype(h.dtype) * jax.nn.gelu(gb)
    return y @ w_out


def sq_relu_mlp(h, w1, w2):
    return jnp.square(jax.nn.relu(h @ w1)) @ w2


def setup_inputs(seed: int = 0) -> dict:
    key = jax.random.key(seed)
    ks = jax.random.split(key, 20)
    f32 = jnp.float32
    nrm = lambda k, shape, scale: jax.random.normal(k, shape, f32) * scale
    s_rg = jax.random.uniform(ks[16], (N_LAYERS_B, D_RNN), f32, 0.9, 0.999) ** (1.0 / RG_C)
    return {
        "x": nrm(ks[0], (BATCH, SEQ, D_MODEL), 1.0),
        "c": nrm(ks[1], (BATCH, D_MODEL), 1.0),
        "ada_w": nrm(ks[2], (DEPTH, 2, D_MODEL, 3 * D_MODEL), 0.5 * D_MODEL ** -0.5),
        "ada_b": nrm(ks[3], (DEPTH, 2, 3 * D_MODEL), 0.02),
        "a_w_in": nrm(ks[4], (N_LAYERS_A, D_MODEL, IN_A), D_MODEL ** -0.5),
        "a_b_gate": jnp.stack([
            nrm(ks[5], (N_LAYERS_A, H_A), 0.1),
            3.0 + 3.0 * jax.random.uniform(ks[6], (N_LAYERS_A, H_A), f32)], axis=1),
        "a_norm_g": 1.0 + nrm(ks[7], (N_LAYERS_A, V_W), 0.02),
        "a_w_out": nrm(ks[8], (N_LAYERS_A, V_W, D_MODEL), V_W ** -0.5),
        "b_w_in": nrm(ks[9], (N_LAYERS_B, D_MODEL, 2 * D_RNN), D_MODEL ** -0.5),
        "b_conv_w": nrm(ks[10], (N_LAYERS_B, CONV_W, D_RNN), CONV_W ** -0.5),
        "b_conv_b": nrm(ks[11], (N_LAYERS_B, D_RNN), 0.02),
        "b_w_ra": nrm(ks[12], (N_LAYERS_B, N_BLOCKS, BLOCK_W, BLOCK_W), BLOCK_W ** -0.5),
        "b_b_ra": nrm(ks[13], (N_LAYERS_B, D_RNN), 0.02),
        "b_w_ri": nrm(ks[14], (N_LAYERS_B, N_BLOCKS, BLOCK_W, BLOCK_W), BLOCK_W ** -0.5),
        "b_b_ri": nrm(ks[15], (N_LAYERS_B, D_RNN), 0.02),
        "b_lam": jnp.log(s_rg / (1.0 - s_rg)),
        "b_w_out": nrm(ks[17], (N_LAYERS_B, D_RNN, D_MODEL), D_RNN ** -0.5),
        "mlp_w1": nrm(ks[18], (DEPTH, D_MODEL, D_FF), D_MODEL ** -0.5),
        "mlp_w2": nrm(ks[19], (DEPTH, D_FF, D_MODEL), D_FF ** -0.5),
        "final_g": 1.0 + nrm(jax.random.fold_in(key, 99), (D_MODEL,), 0.02),
    }


def reference(x, c, ada_w, ada_b, a_w_in, a_b_gate, a_norm_g, a_w_out,
              b_w_in, b_conv_w, b_conv_b, b_w_ra, b_b_ra, b_w_ri, b_b_ri, b_lam, b_w_out,
              mlp_w1, mlp_w2, final_g):
    for layer in range(DEPTH):
        slot = layer // N_MIXERS
        h, gate = ada_modulate(x, c, ada_w[layer, 0], ada_b[layer, 0])
        if layer % N_MIXERS == 0:
            y = mlstm_mixer(h, a_w_in[slot], a_b_gate[slot], a_norm_g[slot], a_w_out[slot])
        else:
            y = rglru_mixer(h, b_w_in[slot], b_conv_w[slot], b_conv_b[slot], b_w_ra[slot], b_b_ra[slot],
                            b_w_ri[slot], b_b_ri[slot], b_lam[slot], b_w_out[slot])
        x = x + gate * y
        h, gate = ada_modulate(x, c, ada_w[layer, 1], ada_b[layer, 1])
        x = x + gate * sq_relu_mlp(h, mlp_w1[layer], mlp_w2[layer])
    return rms_norm(x) * final_g
```

```cpp
#include <hip/hip_runtime.h>
#include <hip/hip_cooperative_groups.h>
#include <cstdio>
namespace cg = cooperative_groups;

#define LAS __attribute__((address_space(3)))
typedef unsigned short bf16_t;
typedef short bf16x8 __attribute__((ext_vector_type(8)));
typedef float f32x4 __attribute__((ext_vector_type(4)));
typedef float f32x2 __attribute__((ext_vector_type(2)));
typedef unsigned u32x4 __attribute__((ext_vector_type(4)));
typedef unsigned u32x2 __attribute__((ext_vector_type(2)));

constexpr int DM = 2048, NBATCH = 4, SEQ = 4096, MTOK = NBATCH * SEQ, DFF = 8192;
constexpr int NH = 8, DQK = 128, DV = 256, CH = 128, NCHUNK = SEQ / CH, INA = 6160;
constexpr int SCH = 32, SCL = SEQ / SCH;
constexpr float EPS = 1e-6f;

constexpr size_t OFF_MOD = 0;
constexpr size_t SZ_MOD = 4ull * 4 * 6144 * 4;
constexpr size_t OFF_BAR = OFF_MOD + SZ_MOD;
constexpr size_t SZ_BAR = 3456 * 4;
constexpr size_t OFF_MOD64 = OFF_BAR + 16384;
constexpr size_t SZ_MOD64 = 4ull * 4 * 6144 * 8;
constexpr size_t OFF_CNT = OFF_MOD64 + SZ_MOD64;
constexpr size_t SZ_CNT = 4ull * 64 * 256;
constexpr size_t OFF_WG16 = OFF_CNT + SZ_CNT;
constexpr size_t OFF_SCAN = OFF_WG16 + 16ull * 2048 * 2;
constexpr size_t OFF_LI = OFF_SCAN + 2ull * 4 * SCH * 2048 * 4;
constexpr size_t OFF_LF = OFF_LI + 4ull * 8 * 4096 * 4;
constexpr size_t OFF_XCH = OFF_LF + 4ull * 8 * 4096 * 4;
constexpr size_t SZ_XCH1 = 64ull * 256 * 8 * 4;
constexpr size_t OFF_W = 8ull << 20;
static_assert(OFF_XCH + 4 * SZ_XCH1 <= OFF_W, "ctl region");
constexpr size_t OFF_W_AIN = OFF_W;
constexpr size_t OFF_W_AOUT = OFF_W_AIN + 6144ull * 2048 * 2;
constexpr size_t OFF_W_BIN = OFF_W_AOUT + 2048ull * 2048 * 2;
constexpr size_t OFF_W_BOUT = OFF_W_BIN + 4096ull * 2048 * 2;
constexpr size_t OFF_W_GATE = OFF_W_BOUT + 2048ull * 2048 * 2;
constexpr size_t OFF_W_1 = OFF_W_GATE + 4096ull * 256 * 2;
constexpr size_t OFF_W_2 = OFF_W_1 + 2ull * 8192 * 2048 * 2;
constexpr size_t OFF_XR = OFF_W_2 + 2ull * 8192 * 2048 * 2;
constexpr size_t OFF_SCR = OFF_XR + (size_t)MTOK * DM * 4;
constexpr size_t SZ_ROWB = (size_t)MTOK * DM * 2;
constexpr size_t S0_HB = OFF_SCR, S0_Q = S0_HB + SZ_ROWB, S0_K = S0_Q + SZ_ROWB / 2, S0_KT = S0_K + SZ_ROWB / 2, S0_VT = S0_KT + SZ_ROWB / 2,
                 S0_O = S0_VT + SZ_ROWB, S0_HH = S0_O + SZ_ROWB, S0_END = S0_HH + 2 * SZ_ROWB, S0_AB = S0_HB;
constexpr size_t SM_U = OFF_SCR + SZ_ROWB, SM_HB = OFF_SCR + 5 * SZ_ROWB;
constexpr size_t S1_HB = OFF_SCR, S1_XB = S1_HB + SZ_ROWB, S1_GB = S1_XB + SZ_ROWB, S1_XC = S1_GB + SZ_ROWB, S1_A = S1_HB, S1_AB = S1_XC;
constexpr size_t WS_NEED = S0_END;

constexpr int L_XB = 148864;
constexpr int LDS_BYTES = L_XB + 64;

typedef __bf16 bf16x2_t __attribute__((ext_vector_type(2)));
__device__ __forceinline__ unsigned cvt_pk_bf16(float lo, float hi) { const bf16x2_t r = __builtin_convertvector((f32x2){lo, hi}, bf16x2_t); return __builtin_bit_cast(unsigned, r); }
__device__ __forceinline__ float bf_lo(unsigned w) { return __uint_as_float(w << 16); }
__device__ __forceinline__ float bf_hi(unsigned w) { return __uint_as_float(w & 0xffff0000u); }
__device__ __forceinline__ float wave_sum(float v) {
#pragma unroll
    for (int o = 1; o < 64; o <<= 1) v += __shfl_xor(v, o);
    return v;
}
__device__ __forceinline__ float sigmoidf_(float x) { return 1.0f / (1.0f + __expf(-x)); }
__device__ __forceinline__ int opaque_tid() { int t = threadIdx.x; asm volatile("" : "+v"(t)); return t; }
#define LDS_FENCE() asm volatile("s_waitcnt lgkmcnt(0)" ::: "memory")
#define WG_BARRIER() do { asm volatile("s_waitcnt vmcnt(0) lgkmcnt(0)" ::: "memory"); __builtin_amdgcn_s_barrier(); asm volatile("" ::: "memory"); } while (0)
#define WG_BARRIER_LDS() do { asm volatile("s_waitcnt lgkmcnt(0)" ::: "memory"); __builtin_amdgcn_s_barrier(); asm volatile("" ::: "memory"); } while (0)


#define XB_TMO      128
#define XB_XCNT(j)  (256  + 64 * (j))
#define XB_XSUB(j)  (1280 + 64 * (j))
#define XB_XGEN(j)  (2304 + 64 * (j))
#define XB_TOP      3328
#define XB_TOPGEN   3392
#define XB_SPIN_CAP (1u << 20)
__device__ __forceinline__ unsigned xb_ld(unsigned* p)              { return __hip_atomic_load(p, __ATOMIC_RELAXED, __HIP_MEMORY_SCOPE_AGENT); }
__device__ __forceinline__ unsigned xb_add(unsigned* p, unsigned v) { return __hip_atomic_fetch_add(p, v, __ATOMIC_RELAXED, __HIP_MEMORY_SCOPE_AGENT); }
__device__ __forceinline__ unsigned xb_xcc_id() { return (unsigned)__builtin_amdgcn_s_getreg((3 << 11) | 20) & 0xFu; }
#define XB_SPIN(cond, bar) do { unsigned _sp = 0; while (cond) { __builtin_amdgcn_s_sleep(1); \
    if ((++_sp & 255u) == 0u) { if (xb_ld(&(bar)[XB_TMO])) break; if (_sp > XB_SPIN_CAP) { atomicAdd(&(bar)[XB_TMO], 1u); break; } } } } while (0)
struct XcdBarrier { unsigned* bar; unsigned x; volatile LAS unsigned* st; };
__device__ __forceinline__ XcdBarrier xcd_barrier_post(unsigned* bar, volatile LAS unsigned* st) {
    XcdBarrier b; b.bar = bar; b.x = xb_xcc_id(); b.st = st;
    if (threadIdx.x == 0) (void)xb_add(&bar[XB_XCNT(b.x)], 1u);
    return b;
}
__device__ __forceinline__ void xcd_barrier_complete(unsigned* bar, unsigned x, unsigned& nloc, unsigned& nx) {
    const unsigned G = gridDim.x * gridDim.y * gridDim.z;
    unsigned sum, cnt, mine, sp = 0u;
    for (;;) {
        sum = 0u; cnt = 0u; mine = 0u;
#pragma unroll
        for (unsigned j = 0; j < 16; ++j) { const unsigned c = xb_ld(&bar[XB_XCNT(j)]); sum += c; cnt += (c > 0u) ? 1u : 0u; mine = (j == x) ? c : mine; }
        if (sum == G) break;
        __builtin_amdgcn_s_sleep(1);
        if ((++sp & 255u) == 0u) { if (xb_ld(&bar[XB_TMO])) break; if (sp > XB_SPIN_CAP) { atomicAdd(&bar[XB_TMO], 1u); break; } }
    }
    nloc = mine > 0u ? mine : 1u; nx = cnt > 0u ? cnt : 1u;
}
__device__ __forceinline__ void xcd_barrier(const XcdBarrier& b) {
    asm volatile("s_waitcnt vmcnt(0)" ::: "memory");
    __syncthreads();
    if (threadIdx.x == 0) {
        unsigned* bar = b.bar;
        __builtin_amdgcn_s_waitcnt(0);
        unsigned nloc = b.st[0], nx = b.st[1];
        if (nloc == 0u) { xcd_barrier_complete(bar, b.x, nloc, nx); b.st[0] = nloc; b.st[1] = nx; }
        const unsigned old = xb_add(&bar[XB_XSUB(b.x)], 1u);
        const unsigned gen = old / nloc;
        if (old + 1u == (gen + 1u) * nloc) {
            __builtin_amdgcn_fence(__ATOMIC_RELEASE, "agent");
            asm volatile("s_waitcnt vmcnt(0)" ::: "memory");
            const unsigned og = xb_add(&bar[XB_TOP], 1u);
            const unsigned tg = og / nx;
            if (og + 1u == (tg + 1u) * nx) xb_add(&bar[XB_TOPGEN], 1u);
            else XB_SPIN(xb_ld(&bar[XB_TOPGEN]) == tg, bar);
            __builtin_amdgcn_fence(__ATOMIC_ACQUIRE, "agent");
            xb_add(&bar[XB_XGEN(b.x)], 1u);
            asm volatile("s_waitcnt vmcnt(0)" ::: "memory");
        } else {
            XB_SPIN(xb_ld(&bar[XB_XGEN(b.x)]) == gen, bar);
            __builtin_amdgcn_fence(__ATOMIC_ACQUIRE, "agent");
            asm volatile("s_waitcnt vmcnt(0)" ::: "memory");
        }
    }
    __syncthreads();
}

struct Params {
    const float *x, *c, *ada_w, *ada_b, *a_w_in, *a_b_gate, *a_norm_g, *a_w_out, *b_w_in, *b_conv_w, *b_conv_b, *b_w_ra, *b_b_ra, *b_w_ri, *b_b_ri, *b_lam,
        *b_w_out, *mlp_w1, *mlp_w2, *final_g;
    float* out;
    unsigned char* ws;
};

constexpr int BM = 256, BK = 64, HALF = 128, HTB = HALF * BK * 2, NXCD = 8, WGM = 8;
__device__ __forceinline__ int lds_byte(int r, int c) { const int st = (r >> 4) * 2 + (c >> 5), rr = r & 15, cc = c & 31, ob = rr * 64 + cc * 2; return st * 1024 + (ob ^ (((ob >> 9) & 1) << 5)); }
__device__ __forceinline__ void stage_rc(int b, int& R, int& C) { const int st = b / 1024, sb = b % 1024, swz = sb ^ (((sb >> 9) & 1) << 5); R = (st >> 1) * 16 + swz / 64; C = (st & 1) * 32 + (swz % 64) / 2; }
__device__ __forceinline__ int perm32(int rho) { const int n = rho >> 4, i = rho & 15; return 8 * (i >> 2) + 4 * n + (i & 3); }
struct Unit { int pm, pn; };
struct StaticOrder {
    int nM, nN, nwg, G, c;
    __device__ void init(int M, int N, int G_, int c_) { nM = M / BM; nN = N / BM; nwg = nM * nN; G = G_; c = c_; }
    __device__ bool next(int i, Unit& u) const {
        const long L = (long)i * G + c; if (L >= nwg) return false;
        int wgid = (int)L; { const int q = nwg / NXCD, r = nwg % NXCD, xcd = wgid % NXCD, off = wgid / NXCD; wgid = (xcd < r ? xcd * (q + 1) : r * (q + 1) + (xcd - r) * q) + off; }
        const int nig = WGM * nN, gid = wgid / nig, fm = gid * WGM, gsz = (nM - fm) < WGM ? (nM - fm) : WGM;
        u.pm = fm + ((wgid % nig) % gsz); u.pn = (wgid % nig) / gsz; return true;
    }
};

template <class Epi>
__device__ __forceinline__ void gemm_phase(LAS unsigned char* lds, const bf16_t* A, int lda, const bf16_t* Bt, int ldb, int M, int N, int K, int asel, const Epi& E, const int fixed_round = -1) {
    const int tid = opaque_tid(), wid = __builtin_amdgcn_readfirstlane(tid >> 6), lane = tid & 63, wr = wid >> 2, wc = wid & 3, fr = lane & 15, fq = lane >> 4;
    const int nt = K / BK;
    constexpr bool NOSWAP = Epi::NOSWAP;
    StaticOrder S; S.init(M, N, gridDim.x, blockIdx.x);
    unsigned voffA[2], voffB[2];
#pragma unroll
    for (int i = 0; i < 2; ++i) { int R, C; stage_rc(tid * 16 + i * 8192, R, C); const int Rb = (int)Epi::PERM == 2 ? (64 * (R >> 5) + perm32(R & 31)) : (Epi::PERM ? ((R & ~31) + perm32(R & 31)) : R);
        voffA[i] = (unsigned)(R * lda + C) * 2u; voffB[i] = (unsigned)(Rb * ldb + C) * 2u; }
    const size_t kstep = (size_t)(BK * 2);
    const size_t hstepA = (size_t)HALF * lda * 2, hstepB = (size_t)((int)Epi::PERM == 2 ? 32 : HALF) * ldb * 2;
    const size_t tstepA = 2 * hstepA, tstepB = (size_t)BM * ldb * 2;
    const unsigned ldsw = (unsigned)wid * 1024u;
    const int aoff = lds_byte(wr * 64 + fr, fq * 8), boff = lds_byte(wc * 32 + fr, fq * 8);
#define PG8_SA(b, h) (((b) * 2 + (h)) * HTB)
#define PG8_SB(b, h) ((4 + (b) * 2 + (h)) * HTB)
#define PG8_STAGE(bufoff, gbase, voff) do { _Pragma("unroll") for (int _i = 0; _i < 2; ++_i) \
        __builtin_amdgcn_global_load_lds((const unsigned*)((const char*)(gbase) + (voff)[_i]), (LAS unsigned*)(lds + (bufoff) + ldsw + _i * 8192), 16, 0, 0); } while (0)
#define PG8_LDA(dst, b, h) do { _Pragma("unroll") for (int m = 0; m < 4; ++m) _Pragma("unroll") for (int k = 0; k < 2; ++k) dst[m][k] = *(const LAS bf16x8*)(lds + PG8_SA(b, h) + aoff + m * 2048 + k * 1024); } while (0)
#define PG8_LDB(dst, b, h) do { _Pragma("unroll") for (int n = 0; n < 2; ++n) _Pragma("unroll") for (int k = 0; k < 2; ++k) dst[n][k] = *(const LAS bf16x8*)(lds + PG8_SB(b, h) + boff + n * 2048 + k * 1024); } while (0)
#define PG8_MMA(ai, bj, At, Bt_) do { __builtin_amdgcn_s_setprio(1); _Pragma("unroll") for (int m = 0; m < 4; ++m) _Pragma("unroll") for (int n = 0; n < 2; ++n) _Pragma("unroll") for (int k = 0; k < 2; ++k) \
        acc[ai][bj][m][n] = NOSWAP ? __builtin_amdgcn_mfma_f32_16x16x32_bf16(At[m][k], Bt_[n][k], acc[ai][bj][m][n], 0, 0, 0) : __builtin_amdgcn_mfma_f32_16x16x32_bf16(Bt_[n][k], At[m][k], acc[ai][bj][m][n], 0, 0, 0); __builtin_amdgcn_s_setprio(0); } while (0)
#define PG8_WAIT_V(n) asm volatile("s_waitcnt vmcnt(" #n ")" ::: "memory")
#define PG8_WAIT_L(n) asm volatile("s_waitcnt lgkmcnt(" #n ")" ::: "memory")
#define PG8_BAR __builtin_amdgcn_s_barrier()
#define PG8_SCHED __builtin_amdgcn_sched_barrier(0)
#define PG8_ABASE(u_) ((const char*)A + (size_t)(u_).pm * tstepA + (asel ? (size_t)((u_).pn >> 1) * 512 : (size_t)0))
    Unit cur, nxt; int ui = 0;
    if (fixed_round < 0) { if (!S.next(0, cur)) return; }
    else { const int c = blockIdx.x; cur.pm = 32 * fixed_round + 4 * (c & 7) + (c >> 6); cur.pn = (c >> 3) & 7; }
    f32x4 acc[2][2][4][2];
#pragma unroll
    for (int a = 0; a < 2; ++a)
#pragma unroll
        for (int b = 0; b < 2; ++b)
#pragma unroll
            for (int m = 0; m < 4; ++m)
#pragma unroll
                for (int n = 0; n < 2; ++n) acc[a][b][m][n] = (f32x4){0.f, 0.f, 0.f, 0.f};
    bf16x8 At[4][2], B0[2][2], B1[2][2];
    const char* cA = PG8_ABASE(cur); const char* cB = (const char*)Bt + (size_t)cur.pn * tstepB;
    PG8_STAGE(PG8_SB(0, 0), cB, voffB); PG8_STAGE(PG8_SA(0, 0), cA, voffA); PG8_STAGE(PG8_SB(0, 1), cB + hstepB, voffB); PG8_STAGE(PG8_SA(0, 1), cA + hstepA, voffA);
    if (wr == 1) PG8_BAR;
    PG8_WAIT_V(4); PG8_BAR;
    PG8_STAGE(PG8_SB(1, 0), cB + kstep, voffB); PG8_STAGE(PG8_SA(1, 0), cA + kstep, voffA); PG8_STAGE(PG8_SB(1, 1), cB + hstepB + kstep, voffB);
    PG8_WAIT_V(6); PG8_BAR;
    for (;;) {
        const bool has_next = (fixed_round < 0) && S.next(ui + 1, nxt);
        const char* nA = has_next ? PG8_ABASE(nxt) : cA; const char* nB = has_next ? (const char*)Bt + (size_t)nxt.pn * tstepB : cB;
        for (int t = 0; t < nt; t += 2) {
            const bool last = (t == nt - 2);
            const char* a1 = cA + (size_t)(t + 1) * kstep;
            const char* a2 = last ? nA : cA + (size_t)(t + 2) * kstep; const char* b2 = last ? nB : cB + (size_t)(t + 2) * kstep;
            const char* a3 = a2 + kstep; const char* b3 = b2 + kstep;
            PG8_LDB(B0, 0, 0); PG8_SCHED; PG8_LDA(At, 0, 0); PG8_STAGE(PG8_SA(1, 1), a1 + hstepA, voffA);
            PG8_WAIT_L(8); PG8_BAR; PG8_WAIT_L(0); PG8_MMA(0, 0, At, B0); PG8_BAR; PG8_SCHED;
            PG8_LDB(B1, 0, 1); PG8_STAGE(PG8_SB(0, 0), b2, voffB);
            PG8_BAR; PG8_WAIT_L(0); PG8_MMA(0, 1, At, B1); PG8_BAR;
            PG8_LDA(At, 0, 1); PG8_STAGE(PG8_SA(0, 0), a2, voffA);
            PG8_BAR; PG8_WAIT_L(0); PG8_MMA(1, 0, At, B0); PG8_BAR; PG8_SCHED;
            PG8_STAGE(PG8_SB(0, 1), b2 + hstepB, voffB);
            PG8_WAIT_V(6); PG8_BAR; PG8_MMA(1, 1, At, B1); PG8_BAR;
            PG8_LDB(B0, 1, 0); PG8_SCHED; PG8_LDA(At, 1, 0); PG8_STAGE(PG8_SA(0, 1), a2 + hstepA, voffA);
            PG8_WAIT_L(8); PG8_BAR; PG8_WAIT_L(0); PG8_MMA(0, 0, At, B0); PG8_BAR; PG8_SCHED;
            PG8_LDB(B1, 1, 1); PG8_STAGE(PG8_SB(1, 0), b3, voffB);
            PG8_BAR; PG8_WAIT_L(0); PG8_MMA(0, 1, At, B1); PG8_BAR;
            PG8_LDA(At, 1, 1); PG8_STAGE(PG8_SA(1, 0), a3, voffA);
            PG8_BAR; PG8_WAIT_L(0); PG8_MMA(1, 0, At, B0); PG8_BAR; PG8_SCHED;
            PG8_STAGE(PG8_SB(1, 1), b3 + hstepB, voffB);
            PG8_WAIT_V(6); PG8_BAR; PG8_MMA(1, 1, At, B1); PG8_BAR;
        }
        if constexpr (!Epi::AFTER_DRAIN) E(acc, cur, wr, wc, fr, fq);
        if (!has_next) break;
#pragma unroll
        for (int a = 0; a < 2; ++a)
#pragma unroll
            for (int b = 0; b < 2; ++b)
#pragma unroll
                for (int m = 0; m < 4; ++m)
#pragma unroll
                    for (int n = 0; n < 2; ++n) acc[a][b][m][n] = (f32x4){0.f, 0.f, 0.f, 0.f};
        cur = nxt; cA = nA; cB = nB; ++ui;
    }
    PG8_WAIT_V(0);
    if (wr == 0) PG8_BAR;
    PG8_BAR;
    if constexpr (Epi::AFTER_DRAIN) E.fused(acc, cur, wr, wc, fr, fq, lds);
#undef PG8_SA
#undef PG8_SB
#undef PG8_STAGE
#undef PG8_LDA
#undef PG8_LDB
#undef PG8_MMA
#undef PG8_WAIT_V
#undef PG8_WAIT_L
#undef PG8_BAR
#undef PG8_SCHED
#undef PG8_ABASE
}

typedef f32x4 AccT[2][2][4][2];

template <bool IN_F32>
struct EpiResid {
    static constexpr int PERM = 2; static constexpr bool NOSWAP = false, AFTER_DRAIN = false;
    const void* Xin; bf16_t* Xout; const float* gate;
    __device__ __forceinline__ void operator()(const AccT& acc, const Unit& u, int wr, int wc, int fr, int fq) const {
        const int row0 = u.pm * BM + wr * 64 + fr, col0 = u.pn * BM + wc * 64 + 8 * fq;
        const float* g = gate + (u.pm >> 4) * 6144 + col0;
        f32x4 gv[2][2];
#pragma unroll
        for (int bj = 0; bj < 2; ++bj)
#pragma unroll
            for (int n = 0; n < 2; ++n) gv[bj][n] = *(const f32x4*)(g + bj * 32 + n * 4);
#pragma unroll
        for (int ai = 0; ai < 2; ++ai) {
            f32x4 xin[4][2][2];
#pragma unroll
            for (int m = 0; m < 4; ++m) { const size_t off = (size_t)(row0 + ai * HALF + m * 16) * DM + col0;
#pragma unroll
                for (int bj = 0; bj < 2; ++bj) {
                    if (IN_F32) { xin[m][bj][0] = *(const f32x4*)((const float*)Xin + off + bj * 32); xin[m][bj][1] = *(const f32x4*)((const float*)Xin + off + bj * 32 + 4); }
                    else { const u32x4 w = *(const u32x4*)((const bf16_t*)Xin + off + bj * 32);
                        xin[m][bj][0] = (f32x4){bf_lo(w.x), bf_hi(w.x), bf_lo(w.y), bf_hi(w.y)}; xin[m][bj][1] = (f32x4){bf_lo(w.z), bf_hi(w.z), bf_lo(w.w), bf_hi(w.w)}; } } }
            asm volatile("" ::: "memory");
#pragma unroll
            for (int m = 0; m < 4; ++m) { const size_t off = (size_t)(row0 + ai * HALF + m * 16) * DM + col0;
#pragma unroll
                for (int bj = 0; bj < 2; ++bj) { const f32x4 v0 = xin[m][bj][0] + gv[bj][0] * acc[ai][bj][m][0], v1 = xin[m][bj][1] + gv[bj][1] * acc[ai][bj][m][1];
                    u32x4 w; w.x = cvt_pk_bf16(v0[0], v0[1]); w.y = cvt_pk_bf16(v0[2], v0[3]); w.z = cvt_pk_bf16(v1[0], v1[1]); w.w = cvt_pk_bf16(v1[2], v1[3]);
                    *(u32x4*)(Xout + off + bj * 32) = w; } }
            asm volatile("" ::: "memory");
        }
    }
};
template <bool IN_F32, bool FINAL>
struct EpiResidNorm {
    static constexpr int PERM = 2; static constexpr bool NOSWAP = false, AFTER_DRAIN = true;
    const void* Xin; bf16_t* Xout; const float* gate; const float* modn; bf16_t* H; const float* fg; float* OUT; unsigned* X; unsigned* cnt;
    __device__ __forceinline__ void fused(AccT& acc, const Unit& u, int wr, int wc, int fr, int fq, LAS unsigned char* lds) const {
        const int tid = opaque_tid(), wid = tid >> 6, lane = tid & 63;
        const int row0 = u.pm * BM + wr * 64 + fr, col0 = u.pn * BM + wc * 64 + 8 * fq, bb = u.pm >> 4;
        LAS float* P = (LAS float*)lds; LAS float* Ssh = (LAS float*)(lds + 8192);
        {
            const float* g = gate + bb * 6144 + col0;
            f32x4 gv[2][2];
#pragma unroll
            for (int bj = 0; bj < 2; ++bj)
#pragma unroll
                for (int n = 0; n < 2; ++n) gv[bj][n] = *(const f32x4*)(g + bj * 32 + n * 4);
#pragma unroll
            for (int ai = 0; ai < 2; ++ai) {
                f32x4 xin[4][2][2];
#pragma unroll
                for (int m = 0; m < 4; ++m) { const size_t off = (size_t)(row0 + ai * HALF + m * 16) * DM + col0;
#pragma unroll
                    for (int bj = 0; bj < 2; ++bj) {
                        if (IN_F32) { xin[m][bj][0] = *(const f32x4*)((const float*)Xin + off + bj * 32); xin[m][bj][1] = *(const f32x4*)((const float*)Xin + off + bj * 32 + 4); }
                        else { const u32x4 w = *(const u32x4*)((const bf16_t*)Xin + off + bj * 32);
                            xin[m][bj][0] = (f32x4){bf_lo(w.x), bf_hi(w.x), bf_lo(w.y), bf_hi(w.y)}; xin[m][bj][1] = (f32x4){bf_lo(w.z), bf_hi(w.z), bf_lo(w.w), bf_hi(w.w)}; } } }
                asm volatile("" ::: "memory");
#pragma unroll
                for (int m = 0; m < 4; ++m) { const size_t off = (size_t)(row0 + ai * HALF + m * 16) * DM + col0;
#pragma unroll
                    for (int bj = 0; bj < 2; ++bj) { const f32x4 v0 = xin[m][bj][0] + gv[bj][0] * acc[ai][bj][m][0], v1 = xin[m][bj][1] + gv[bj][1] * acc[ai][bj][m][1];
                        u32x4 w; w.x = cvt_pk_bf16(v0[0], v0[1]); w.y = cvt_pk_bf16(v0[2], v0[3]); w.z = cvt_pk_bf16(v1[0], v1[1]); w.w = cvt_pk_bf16(v1[2], v1[3]);
                        if (!FINAL) *(u32x4*)(Xout + off + bj * 32) = w;
                        acc[ai][bj][m][0] = (f32x4){bf_lo(w.x), bf_hi(w.x), bf_lo(w.y), bf_hi(w.y)}; acc[ai][bj][m][1] = (f32x4){bf_lo(w.z), bf_hi(w.z), bf_lo(w.w), bf_hi(w.w)}; } }
                asm volatile("" ::: "memory");
            }
        }
#pragma unroll
        for (int ai = 0; ai < 2; ++ai)
#pragma unroll
            for (int m = 0; m < 4; ++m) { float sq = 0.f;
#pragma unroll
                for (int bj = 0; bj < 2; ++bj)
#pragma unroll
                    for (int n = 0; n < 2; ++n) { const f32x4 x = acc[ai][bj][m][n]; sq += (x[0] * x[0] + x[1] * x[1]) + (x[2] * x[2] + x[3] * x[3]); }
                sq += __shfl_xor(sq, 16); sq += __shfl_xor(sq, 32);
                if (fq == 0) P[(ai * HALF + wr * 64 + m * 16 + fr) * 4 + wc] = sq; }
        WG_BARRIER_LDS();
        if (tid < 256) { const float t = (P[tid * 4] + P[tid * 4 + 1]) + (P[tid * 4 + 2] + P[tid * 4 + 3]);
            __hip_atomic_store(X + ((size_t)u.pm * 256 + tid) * 8 + u.pn, __float_as_uint(t), __ATOMIC_RELAXED, __HIP_MEMORY_SCOPE_AGENT); }
        asm volatile("s_waitcnt vmcnt(0)" ::: "memory");
        if (tid < 256 && lane == 0) __hip_atomic_fetch_add(cnt + 64 * u.pm, 1u, __ATOMIC_RELAXED, __HIP_MEMORY_SCOPE_AGENT);
        if (wid == 0) { unsigned spins = 0;
            while ((unsigned)__builtin_amdgcn_readfirstlane((int)__hip_atomic_load(cnt + 64 * u.pm, __ATOMIC_RELAXED, __HIP_MEMORY_SCOPE_AGENT)) < 32u) { __builtin_amdgcn_s_sleep(1); if (++spins > (1u << 22)) break; }
            __builtin_amdgcn_fence(__ATOMIC_ACQUIRE, "agent");
            asm volatile("s_waitcnt vmcnt(0)" ::: "memory"); }
        WG_BARRIER();
        if (tid < 256) { const unsigned* xp = X + ((size_t)u.pm * 256 + tid) * 8; float t = 0.f;
#pragma unroll
            for (int q = 0; q < 8; ++q) t += __uint_as_float(__hip_atomic_load(xp + q, __ATOMIC_RELAXED, __HIP_MEMORY_SCOPE_AGENT));
            Ssh[tid] = rsqrtf(t * (1.0f / DM) + EPS); }
        WG_BARRIER();
        f32x4 c0[2][2], c1[2][2];
#pragma unroll
        for (int bj = 0; bj < 2; ++bj)
#pragma unroll
            for (int n = 0; n < 2; ++n) { const int col = col0 + bj * 32 + n * 4;
                if (FINAL) { c0[bj][n] = *(const f32x4*)(fg + col); c1[bj][n] = (f32x4){0.f, 0.f, 0.f, 0.f}; }
                else { c0[bj][n] = *(const f32x4*)(modn + bb * 6144 + DM + col) + 1.0f; c1[bj][n] = *(const f32x4*)(modn + bb * 6144 + col); } }
#pragma unroll
        for (int ai = 0; ai < 2; ++ai)
#pragma unroll
            for (int m = 0; m < 4; ++m) { const int rl = ai * HALF + wr * 64 + m * 16 + fr; const float rstd = Ssh[rl]; const size_t off = (size_t)(row0 + ai * HALF + m * 16) * DM + col0;
#pragma unroll
                for (int bj = 0; bj < 2; ++bj) { const f32x4 o0 = acc[ai][bj][m][0] * rstd * c0[bj][0] + c1[bj][0], o1 = acc[ai][bj][m][1] * rstd * c0[bj][1] + c1[bj][1];
                    if (FINAL) { *(f32x4*)(OUT + off + bj * 32) = o0; *(f32x4*)(OUT + off + bj * 32 + 4) = o1; }
                    else { u32x4 w; w.x = cvt_pk_bf16(o0[0], o0[1]); w.y = cvt_pk_bf16(o0[2], o0[3]); w.z = cvt_pk_bf16(o1[0], o1[1]); w.w = cvt_pk_bf16(o1[2], o1[3]);
                        *(u32x4*)(H + off + bj * 32) = w; } } }
        WG_BARRIER_LDS();
    }
};
struct EpiSqRelu {
    static constexpr int PERM = 2; static constexpr bool NOSWAP = false, AFTER_DRAIN = false;
    bf16_t* O;
    __device__ __forceinline__ void operator()(const AccT& acc, const Unit& u, int wr, int wc, int fr, int fq) const {
        const int row0 = u.pm * BM + wr * 64 + fr, col0 = u.pn * BM + wc * 64 + 8 * fq;
#pragma unroll
        for (int ai = 0; ai < 2; ++ai)
#pragma unroll
            for (int m = 0; m < 4; ++m) { bf16_t* rowp = O + (size_t)(row0 + ai * HALF + m * 16) * DFF + col0;
#pragma unroll
                for (int bj = 0; bj < 2; ++bj) { f32x4 v0 = acc[ai][bj][m][0], v1 = acc[ai][bj][m][1];
#pragma unroll
                    for (int j = 0; j < 4; ++j) { float a = fmaxf(v0[j], 0.f), b = fmaxf(v1[j], 0.f); v0[j] = a * a; v1[j] = b * b; }
                    u32x4 w; w.x = cvt_pk_bf16(v0[0], v0[1]); w.y = cvt_pk_bf16(v0[2], v0[3]); w.z = cvt_pk_bf16(v1[0], v1[1]); w.w = cvt_pk_bf16(v1[2], v1[3]);
                    *(u32x4*)(rowp + bj * 32) = w; } }
    }
};
struct EpiProj {
    static constexpr int PERM = 2; static constexpr bool NOSWAP = false, AFTER_DRAIN = false;
    bf16_t *Q, *Kn, *KT, *VT, *O; int pn_off;
    __device__ __forceinline__ void operator()(const AccT& acc, const Unit& u, int wr, int wc, int fr, int fq) const {
        const int row0 = u.pm * BM + wr * 64 + fr;
        const int pn = u.pn + pn_off;
        const int cl = wc * 64 + 8 * fq;
        if (pn < 8) {
            bf16_t* base = pn < 4 ? Q : Kn; const int colt = (pn & 3) * BM; const float sc = pn < 4 ? 0.08838834764831845f : 1.0f;
#pragma unroll
            for (int ai = 0; ai < 2; ++ai)
#pragma unroll
                for (int m = 0; m < 4; ++m) { bf16_t* rowp = base + (size_t)(row0 + ai * HALF + m * 16) * 1024 + colt + cl;
#pragma unroll
                    for (int bj = 0; bj < 2; ++bj) { const f32x4 v0 = acc[ai][bj][m][0] * sc, v1 = acc[ai][bj][m][1] * sc;
                        u32x4 w; w.x = cvt_pk_bf16(v0[0], v0[1]); w.y = cvt_pk_bf16(v0[2], v0[3]); w.z = cvt_pk_bf16(v1[0], v1[1]); w.w = cvt_pk_bf16(v1[2], v1[3]);
                        *(u32x4*)(rowp + bj * 32) = w; } }
        }
        if (pn >= 16) {
            const int colt = (pn - 16) * BM;
#pragma unroll
            for (int ai = 0; ai < 2; ++ai)
#pragma unroll
                for (int m = 0; m < 4; ++m) { bf16_t* rowp = O + (size_t)(row0 + ai * HALF + m * 16) * DM + colt + cl;
#pragma unroll
                    for (int bj = 0; bj < 2; ++bj) { const f32x4 v0 = acc[ai][bj][m][0], v1 = acc[ai][bj][m][1];
                        u32x4 w; w.x = cvt_pk_bf16(v0[0], v0[1]); w.y = cvt_pk_bf16(v0[2], v0[3]); w.z = cvt_pk_bf16(v1[0], v1[1]); w.w = cvt_pk_bf16(v1[2], v1[3]);
                        *(u32x4*)(rowp + bj * 32) = w; } }
        }
        if (pn >= 4 && pn < 16) {
            const bool isk = pn < 8;
            bf16_t* base = isk ? KT : VT;
            const int feat0 = (isk ? (pn - 4) : (pn - 8)) * BM;
            const int bb = u.pm >> 4; const int s0 = (u.pm & 15) * BM + wr * 64 + fr;
            const size_t bbase = (size_t)bb * (isk ? 1024 : 2048);
#pragma unroll
            for (int ai = 0; ai < 2; ++ai)
#pragma unroll
                for (int m = 0; m < 4; ++m) { const int s = s0 + ai * HALF + m * 16;
#pragma unroll
                    for (int bj = 0; bj < 2; ++bj)
#pragma unroll
                        for (int n = 0; n < 2; ++n)
#pragma unroll
                            for (int j = 0; j < 4; ++j) { const int feat = feat0 + bj * 32 + cl + 4 * n + j;
                                const unsigned w = cvt_pk_bf16(acc[ai][bj][m][n][j], 0.f);
                                base[(bbase + feat) * SEQ + s] = (bf16_t)(w & 0xffffu); } }
        }
    }
};
struct EpiVT {
    static constexpr bool PERM = false, NOSWAP = true, AFTER_DRAIN = false;
    bf16_t* VT;
    __device__ __forceinline__ void operator()(const AccT& acc, const Unit& u, int wr, int wc, int fr, int fq) const {
        const int bb = u.pm >> 4, s0 = (u.pm & 15) * BM + wr * 64 + 4 * fq, feat0 = u.pn * BM + wc * 32 + fr;
#pragma unroll
        for (int bj = 0; bj < 2; ++bj)
#pragma unroll
            for (int n = 0; n < 2; ++n) { bf16_t* fp = VT + ((size_t)bb * 2048 + feat0 + bj * HALF + n * 16) * SEQ + s0;
#pragma unroll
                for (int ai = 0; ai < 2; ++ai)
#pragma unroll
                    for (int m = 0; m < 4; ++m) { const f32x4 v = acc[ai][bj][m][n]; u32x2 w; w.x = cvt_pk_bf16(v[0], v[1]); w.y = cvt_pk_bf16(v[2], v[3]);
                        *(u32x2*)(fp + ai * HALF + m * 16) = w; } }
    }
};
struct EpiRgIn {
    static constexpr int PERM = 2; static constexpr bool NOSWAP = false, AFTER_DRAIN = false;
    bf16_t *XB, *GB;
    __device__ __forceinline__ void operator()(const AccT& acc, const Unit& u, int wr, int wc, int fr, int fq) const {
        const int row0 = u.pm * BM + wr * 64 + fr; const bool isg = u.pn >= 8;
        bf16_t* base = isg ? GB : XB; const int col0 = (u.pn & 7) * BM + wc * 64 + 8 * fq;
#pragma unroll
        for (int ai = 0; ai < 2; ++ai)
#pragma unroll
            for (int m = 0; m < 4; ++m) { bf16_t* rowp = base + (size_t)(row0 + ai * HALF + m * 16) * DM + col0;
#pragma unroll
                for (int bj = 0; bj < 2; ++bj) { f32x4 v0 = acc[ai][bj][m][0], v1 = acc[ai][bj][m][1];
                    if (isg) {
#pragma unroll
                        for (int j = 0; j < 4; ++j) { float a = v0[j], b = v1[j];
                            const float ta = 1.5957691216057308f * (a + 0.044715f * a * a * a), tb = 1.5957691216057308f * (b + 0.044715f * b * b * b);
                            v0[j] = a * __builtin_amdgcn_rcpf(1.0f + __expf(-ta)); v1[j] = b * __builtin_amdgcn_rcpf(1.0f + __expf(-tb)); } }
                    u32x4 w; w.x = cvt_pk_bf16(v0[0], v0[1]); w.y = cvt_pk_bf16(v0[2], v0[3]); w.z = cvt_pk_bf16(v1[0], v1[1]); w.w = cvt_pk_bf16(v1[2], v1[3]);
                    *(u32x4*)(rowp + bj * 32) = w; } }
    }
};
struct EpiGate {
    static constexpr bool PERM = false, NOSWAP = false, AFTER_DRAIN = false;
    const bf16_t* XC; const float *b_ra, *b_ri, *lam; unsigned* AU;
    __device__ __forceinline__ void operator()(const AccT& acc, const Unit& u, int wr, int wc, int fr, int fq) const {
        const int row0 = u.pm * BM + wr * 64 + fr, ch0 = u.pn * HALF + wc * 32 + 4 * fq;
#pragma unroll
        for (int n = 0; n < 2; ++n) {
            u32x2 xw[2][4];
#pragma unroll
            for (int ai = 0; ai < 2; ++ai)
#pragma unroll
                for (int m = 0; m < 4; ++m) xw[ai][m] = *(const u32x2*)(XC + (size_t)(row0 + ai * HALF + m * 16) * DM + ch0 + 16 * n);
            const f32x4 bra = *(const f32x4*)(b_ra + ch0 + 16 * n), bri = *(const f32x4*)(b_ri + ch0 + 16 * n), l = *(const f32x4*)(lam + ch0 + 16 * n);
            f32x4 sp;
#pragma unroll
            for (int j = 0; j < 4; ++j) sp[j] = -8.0f * log1pf(__expf(-l[j]));
#pragma unroll
            for (int ai = 0; ai < 2; ++ai)
#pragma unroll
                for (int m = 0; m < 4; ++m) { const size_t off = (size_t)(row0 + ai * HALF + m * 16) * DM + ch0 + 16 * n;
                    const f32x4 rp = acc[ai][0][m][n] + bra, ip = acc[ai][1][m][n] + bri;
                    const u32x2 w = xw[ai][m]; const float xv[4] = {bf_lo(w.x), bf_hi(w.x), bf_lo(w.y), bf_hi(w.y)};
                    u32x4 o;
#pragma unroll
                    for (int j = 0; j < 4; ++j) { const float r = __builtin_amdgcn_rcpf(1.0f + __expf(-rp[j])), ig = __builtin_amdgcn_rcpf(1.0f + __expf(-ip[j])); const float la = sp[j] * r; const float d = 1.0f - __expf(la);
                        o[j] = cvt_pk_bf16(d, __builtin_amdgcn_sqrtf(fmaxf(d * (2.0f - d), 0.f)) * (ig * xv[j])); }
                    *(u32x4*)(AU + off) = o; }
        }
    }
};

__device__ __forceinline__ void transpose_item(const float* src, int ldsrc, bf16_t* dst, int lddst, int kt, int ntile, LAS float* scr, int lane) {
    const int k0 = kt * 64, n0 = ntile * 64, l16 = lane & 15, l4 = lane >> 4;
    f32x4 tv[16];
#pragma unroll
    for (int i = 0; i < 16; ++i) tv[i] = *(const f32x4*)(src + (size_t)(k0 + l4 + 4 * i) * ldsrc + n0 + 4 * l16);
#pragma unroll
    for (int i = 0; i < 16; ++i) { const int kk = l4 + 4 * i; const f32x4 v = tv[i];
        LAS float* d = scr + kk * 65 + 4 * l16; d[0] = v[0]; d[1] = v[1]; d[2] = v[2]; d[3] = v[3]; }
    LDS_FENCE();
    const int c = lane & 7;
#pragma unroll
    for (int j = 0; j < 8; ++j) { const int n = (lane >> 3) + 8 * j; const LAS float* s = scr + (8 * c) * 65 + n;
        u32x4 o; o.x = cvt_pk_bf16(s[0], s[65]); o.y = cvt_pk_bf16(s[2 * 65], s[3 * 65]); o.z = cvt_pk_bf16(s[4 * 65], s[5 * 65]); o.w = cvt_pk_bf16(s[6 * 65], s[7 * 65]);
        *(u32x4*)(dst + (size_t)(n0 + n) * lddst + k0 + 8 * c) = o; }
    LDS_FENCE();
}
__device__ __forceinline__ void gemv_item(const Params& p, unsigned long long* MOD, int it, LAS float* scr, int lane) {
    const int mat = it / 1536, rem = it % 1536, cb = rem >> 6, ks = rem & 63, k0 = ks * 32, n0 = cb * 256 + 4 * lane;
#pragma unroll
    for (int i = 0; i < 2; ++i) { const int idx = lane + 64 * i, b = idx >> 5, kk = idx & 31; const float cv = p.c[b * DM + k0 + kk]; scr[idx] = cv / (1.0f + __expf(-cv)); }
    LDS_FENCE();
    const float* W = p.ada_w + (size_t)mat * DM * 6144 + (size_t)k0 * 6144 + n0;
    f32x4 a0 = {0, 0, 0, 0}, a1 = a0, a2 = a0, a3 = a0;
#pragma unroll 16
    for (int kk = 0; kk < 32; ++kk) { const f32x4 w = *(const f32x4*)(W + (size_t)kk * 6144);
        a0 += w * scr[kk]; a1 += w * scr[32 + kk]; a2 += w * scr[64 + kk]; a3 += w * scr[96 + kk]; }
    if (ks == 0) { const f32x4 bv = *(const f32x4*)(p.ada_b + mat * 6144 + n0); a0 += bv; a1 += bv; a2 += bv; a3 += bv; }
    unsigned long long* o = MOD + (size_t)mat * 4 * 6144 + n0;
#pragma unroll
    for (int j = 0; j < 4; ++j) { atomicAdd(o + j, (unsigned long long)__float2ll_rn(a0[j] * 1099511627776.0f)); atomicAdd(o + 6144 + j, (unsigned long long)__float2ll_rn(a1[j] * 1099511627776.0f));
        atomicAdd(o + 2 * 6144 + j, (unsigned long long)__float2ll_rn(a2[j] * 1099511627776.0f)); atomicAdd(o + 3 * 6144 + j, (unsigned long long)__float2ll_rn(a3[j] * 1099511627776.0f)); }
    LDS_FENCE();
}
__device__ __forceinline__ void phase0(const Params& p, LAS unsigned char* lds, const bool do_gemv = true) {
    const int tid = opaque_tid(), lane = tid & 63, wave = __builtin_amdgcn_readfirstlane(tid >> 6);
    const int G = gridDim.x, gw = blockIdx.x * 8 + wave, NGW = G * 8;
    LAS float* scr = (LAS float*)(lds + wave * 16640);
    unsigned char* ws = p.ws;
    { bf16_t* WG16 = (bf16_t*)(ws + OFF_WG16);
      for (int idx = blockIdx.x * 512 + tid; idx < 16 * 2048; idx += G * 512) { const int g = idx & 15, k = idx >> 4;
          const unsigned w = cvt_pk_bf16(p.a_w_in[(size_t)k * INA + 6144 + g], 0.f); WG16[g * 2048 + k] = (bf16_t)(w & 0xffffu); } }
    constexpr int I_GEMV = 6144, I_AIN = 32 * 96, I_SQ = 32 * 32, I_BIN = 32 * 64, I_MLP = 32 * 128, I_GATE = 256;
    constexpr int NITEMS = I_GEMV + I_AIN + 2 * I_SQ + I_BIN + 4 * I_MLP + I_GATE;
    unsigned long long* MOD = (unsigned long long*)(ws + OFF_MOD64);
    for (int it = gw; it < NITEMS; it += NGW) {
        int r = it;
        if (r < I_GEMV) { if (do_gemv) gemv_item(p, MOD, r, scr, lane); continue; } r -= I_GEMV;
        if (r < I_AIN) { transpose_item(p.a_w_in, INA, (bf16_t*)(ws + OFF_W_AIN), 2048, r / 96, r % 96, scr, lane); continue; } r -= I_AIN;
        if (r < I_SQ) { transpose_item(p.a_w_out, 2048, (bf16_t*)(ws + OFF_W_AOUT), 2048, r / 32, r % 32, scr, lane); continue; } r -= I_SQ;
        if (r < I_SQ) { transpose_item(p.b_w_out, 2048, (bf16_t*)(ws + OFF_W_BOUT), 2048, r / 32, r % 32, scr, lane); continue; } r -= I_SQ;
        if (r < I_BIN) { transpose_item(p.b_w_in, 4096, (bf16_t*)(ws + OFF_W_BIN), 2048, r / 64, r % 64, scr, lane); continue; } r -= I_BIN;
        if (r < 2 * I_MLP) { const int l = r / I_MLP, q = r % I_MLP; transpose_item(p.mlp_w1 + (size_t)l * DM * DFF, DFF, (bf16_t*)(ws + OFF_W_1) + (size_t)l * DFF * DM, DM, q / 128, q % 128, scr, lane); continue; } r -= 2 * I_MLP;
        if (r < 2 * I_MLP) { const int l = r / I_MLP, q = r % I_MLP; transpose_item(p.mlp_w2 + (size_t)l * DM * DFF, DM, (bf16_t*)(ws + OFF_W_2) + (size_t)l * DFF * DM, DFF, q / 32, q % 32, scr, lane); continue; } r -= 2 * I_MLP;
        { const int sub = r >> 3, q = r & 7, kt = q >> 1, ntile = q & 1, nb = sub >> 2, gate = (sub >> 1) & 1, dh = sub & 1;
          const float* src = (gate ? p.b_w_ri : p.b_w_ra) + (size_t)nb * 65536 + dh * 128;
          bf16_t* dst = (bf16_t*)(ws + OFF_W_GATE) + (size_t)((nb * 2 + dh) * 256 + gate * 128) * 256;
          transpose_item(src, 256, dst, 256, kt, ntile, scr, lane); }
    }
}

__device__ __forceinline__ f32x4 ld_fx4(const unsigned long long* p) {
    const long long a = (long long)p[0], b = (long long)p[1], c = (long long)p[2], d = (long long)p[3];
    return (f32x4){(float)a, (float)b, (float)c, (float)d} * 9.094947017729282e-13f;
}
template <bool FINAL>
__device__ __forceinline__ void norm_phase(const float* X, const float* mod, bf16_t* H, const float* fg, float* OUT, const unsigned long long* acc64 = nullptr, float* modf = nullptr) {
    const int tid = opaque_tid(), lane = tid & 63, wave = tid >> 6;
    const int gw = blockIdx.x * 8 + wave, NGW = gridDim.x * 8;
    if (acc64) for (int i = blockIdx.x * 512 + tid; i < 4 * 4 * 6144; i += gridDim.x * 512) modf[i] = (float)(long long)acc64[i] * 9.094947017729282e-13f;
    for (int r = gw; r < MTOK; r += NGW) {
        const f32x4* xr = (const f32x4*)(X + (size_t)r * DM) + lane;
        f32x4 v[8]; float ss = 0.f;
#pragma unroll
        for (int j = 0; j < 8; ++j) { v[j] = xr[64 * j]; ss += (v[j][0] * v[j][0] + v[j][1] * v[j][1]) + (v[j][2] * v[j][2] + v[j][3] * v[j][3]); }
        const float rstd = rsqrtf(wave_sum(ss) * (1.0f / DM) + EPS);
        if (FINAL) {
#pragma unroll
            for (int j = 0; j < 8; ++j) { const f32x4 g = *((const f32x4*)fg + lane + 64 * j); *((f32x4*)(OUT + (size_t)r * DM) + lane + 64 * j) = v[j] * rstd * g; }
        } else {
            const float* mb = mod + (r >> 12) * 6144; const unsigned long long* mb64 = acc64 + (r >> 12) * 6144;
#pragma unroll
            for (int j = 0; j < 8; ++j) { const f32x4 sh = acc64 ? ld_fx4(mb64 + 4 * (lane + 64 * j)) : *((const f32x4*)mb + lane + 64 * j), sc = acc64 ? ld_fx4(mb64 + DM + 4 * (lane + 64 * j)) : *((const f32x4*)(mb + DM) + lane + 64 * j);
                const f32x4 o = v[j] * rstd * (sc + 1.0f) + sh; u32x2 w; w.x = cvt_pk_bf16(o[0], o[1]); w.y = cvt_pk_bf16(o[2], o[3]);
                *((u32x2*)(H + (size_t)r * DM) + lane + 64 * j) = w; }
        }
    }
}
template <bool FINAL>
__device__ __forceinline__ void norm_phase_b(const bf16_t* X, const float* mod, bf16_t* H, const float* fg, float* OUT) {
    const int tid = opaque_tid(), lane = tid & 63, wave = tid >> 6;
    const int gw = blockIdx.x * 8 + wave, NGW = gridDim.x * 8;
    for (int rb = gw; rb < MTOK / 2; rb += NGW) {
        u32x4 raw[2][4];
#pragma unroll
        for (int q = 0; q < 2; ++q)
#pragma unroll
            for (int j = 0; j < 4; ++j) raw[q][j] = *((const u32x4*)(X + (size_t)(2 * rb + q) * DM) + lane + 64 * j);
#pragma unroll
        for (int q = 0; q < 2; ++q) {
            const int r = 2 * rb + q;
            f32x4 v[4][2]; float ss = 0.f;
#pragma unroll
            for (int j = 0; j < 4; ++j) { const u32x4 w = raw[q][j];
                v[j][0] = (f32x4){bf_lo(w.x), bf_hi(w.x), bf_lo(w.y), bf_hi(w.y)}; v[j][1] = (f32x4){bf_lo(w.z), bf_hi(w.z), bf_lo(w.w), bf_hi(w.w)};
#pragma unroll
                for (int h = 0; h < 2; ++h) ss += (v[j][h][0] * v[j][h][0] + v[j][h][1] * v[j][h][1]) + (v[j][h][2] * v[j][h][2] + v[j][h][3] * v[j][h][3]); }
            const float rstd = rsqrtf(wave_sum(ss) * (1.0f / DM) + EPS);
            if (FINAL) {
#pragma unroll
                for (int j = 0; j < 4; ++j)
#pragma unroll
                    for (int h = 0; h < 2; ++h) { const int col = 8 * lane + 512 * j + 4 * h; const f32x4 g = *(const f32x4*)(fg + col); *(f32x4*)(OUT + (size_t)r * DM + col) = v[j][h] * rstd * g; }
            } else {
                const float* mb = mod + (r >> 12) * 6144;
#pragma unroll
                for (int j = 0; j < 4; ++j) { f32x4 o[2];
#pragma unroll
                    for (int h = 0; h < 2; ++h) { const int col = 8 * lane + 512 * j + 4 * h; const f32x4 sh = *(const f32x4*)(mb + col), sc = *(const f32x4*)(mb + DM + col); o[h] = v[j][h] * rstd * (sc + 1.0f) + sh; }
                    u32x4 w; w.x = cvt_pk_bf16(o[0][0], o[0][1]); w.y = cvt_pk_bf16(o[0][2], o[0][3]); w.z = cvt_pk_bf16(o[1][0], o[1][1]); w.w = cvt_pk_bf16(o[1][2], o[1][3]);
                    *((u32x4*)(H + (size_t)r * DM) + lane + 64 * j) = w; }
            }
        }
    }
}
__device__ __forceinline__ void headnorm_phase(const bf16_t* HH, const bf16_t* O, const float* ng, bf16_t* AB) {
    const int tid = opaque_tid(), lane = tid & 63, wave = tid >> 6;
    const int gw = blockIdx.x * 8 + wave, NGW = gridDim.x * 8;
    for (int r = gw; r < MTOK; r += NGW) {
        const u32x4* xr = (const u32x4*)(HH + (size_t)r * DM) + lane; const u32x4* orow = (const u32x4*)(O + (size_t)r * DM) + lane;
        u32x4 hv[4], ov[4];
#pragma unroll
        for (int j = 0; j < 4; ++j) { hv[j] = xr[64 * j]; ov[j] = orow[64 * j]; }
#pragma unroll
        for (int j = 0; j < 4; ++j) {
            const f32x4 v0 = {bf_lo(hv[j].x), bf_hi(hv[j].x), bf_lo(hv[j].y), bf_hi(hv[j].y)}, v1 = {bf_lo(hv[j].z), bf_hi(hv[j].z), bf_lo(hv[j].w), bf_hi(hv[j].w)};
            float ss = (v0[0] * v0[0] + v0[1] * v0[1]) + (v0[2] * v0[2] + v0[3] * v0[3]) + (v1[0] * v1[0] + v1[1] * v1[1]) + (v1[2] * v1[2] + v1[3] * v1[3]);
#pragma unroll
            for (int o = 1; o < 32; o <<= 1) ss += __shfl_xor(ss, o);
            const float rs = rsqrtf(ss * (1.0f / DV) + EPS);
            const int col = 8 * lane + 512 * j; const f32x4 g0 = *(const f32x4*)(ng + col), g1 = *(const f32x4*)(ng + col + 4);
            const f32x4 o0 = {bf_lo(ov[j].x), bf_hi(ov[j].x), bf_lo(ov[j].y), bf_hi(ov[j].y)}, o1 = {bf_lo(ov[j].z), bf_hi(ov[j].z), bf_lo(ov[j].w), bf_hi(ov[j].w)};
            f32x4 r0, r1;
#pragma unroll
            for (int q = 0; q < 4; ++q) { r0[q] = v0[q] * rs * g0[q] * sigmoidf_(o0[q]); r1[q] = v1[q] * rs * g1[q] * sigmoidf_(o1[q]); }
            u32x4 w; w.x = cvt_pk_bf16(r0[0], r0[1]); w.y = cvt_pk_bf16(r0[2], r0[3]); w.z = cvt_pk_bf16(r1[0], r1[1]); w.w = cvt_pk_bf16(r1[2], r1[3]);
            *((u32x4*)(AB + (size_t)r * DM) + lane + 64 * j) = w; }
    }
}

__device__ __forceinline__ float log_sigmoidf_(float x) { return fminf(x, 0.f) - log1pf(__expf(-fabsf(x))); }
__device__ __forceinline__ void gates_phase(const bf16_t* HB, const bf16_t* WG16, const float* bg, float* LI, float* LF) {
    const int tid = opaque_tid(), lane = tid & 63, wave = tid >> 6, fr = lane & 15, fq = lane >> 4;
    for (int rt = wave * gridDim.x + blockIdx.x; rt < MTOK / 16; rt += 8 * gridDim.x) {
        const bf16_t* ap = HB + (size_t)(rt * 16 + fr) * DM + 8 * fq; const bf16_t* bp = WG16 + fr * DM + 8 * fq;
        f32x4 acc = {0.f, 0.f, 0.f, 0.f};
#pragma unroll 16
        for (int kk = 0; kk < 64; ++kk) { const bf16x8 a = *(const bf16x8*)(ap + 32 * kk), b = *(const bf16x8*)(bp + 32 * kk);
            acc = __builtin_amdgcn_mfma_f32_16x16x32_bf16(a, b, acc, 0, 0, 0); }
        const int r0 = rt * 16 + 4 * fq, bb = r0 >> 12, s = r0 & 4095, g = fr & 7;
        const float bias = bg[fr];
        f32x4 o;
        if (fr < 8) { o = acc + bias; *(f32x4*)(LI + (size_t)(bb * 8 + g) * SEQ + s) = o; }
        else {
#pragma unroll
            for (int j = 0; j < 4; ++j) o[j] = log_sigmoidf_(acc[j] + bias);
            *(f32x4*)(LF + (size_t)(bb * 8 + g) * SEQ + s) = o; }
    }
}

constexpr int RS = 272;
constexpr int L_Q = 0, L_K = 34816, L_KT = 69632, L_VT = 104448, L_CT = 117504  , L_SC = 143616  ;
constexpr int SC_FLOATS = 656;
__device__ __forceinline__ void mlstm_phase(LAS unsigned char* lds, const bf16_t* Q, const bf16_t* Kn, const bf16_t* KT, const bf16_t* VT, const float* LI, const float* LF, bf16_t* HH) {
    const int tid = opaque_tid(), lane = tid & 63, w = __builtin_amdgcn_readfirstlane(tid >> 6), fr = lane & 15, fq = lane >> 4;
    for (int item = blockIdx.x; item < NBATCH * NH * 8; item += gridDim.x) {
        const int xcd = item & 7, slot = item >> 3, eb = slot & 7, bh = xcd * 4 + (slot >> 3), hh = bh & 7, bb = bh >> 3;
        WG_BARRIER();
        for (int i = tid; i < 2 * 13056 / 4; i += 512) *(LAS unsigned*)(lds + L_CT + 4 * i) = 0u;
        for (int i = tid; i < 16 * RS / 4; i += 512) *(LAS unsigned*)(lds + L_VT + 32 * RS + 4 * i) = (i < RS / 4) ? 0x3F803F80u : 0u;
        const bf16_t* gQ = Q + (size_t)bb * SEQ * 1024 + hh * 128;
        const bf16_t* gK = Kn + (size_t)bb * SEQ * 1024 + hh * 128;
        const bf16_t* gKT = KT + (size_t)(bb * 8 + hh) * 128 * SEQ;
        const bf16_t* gVT = VT + ((size_t)(bb * 8 + hh) * 256 + eb * 32) * SEQ;
        const float* gLI = LI + (size_t)(bb * 8 + hh) * SEQ; const float* gLF = LF + (size_t)(bb * 8 + hh) * SEQ;
        bf16_t* gH = HH + (size_t)bb * SEQ * DM + hh * 256 + eb * 32;
        u32x4 rq[4], rk[4], rkt[4], rvt; f32x2 rli = {0.f, 0.f}, rlf = {0.f, 0.f};
        const int prow = tid >> 4, pseg = tid & 15;
        float m_prev = 0.f;
#define ML_LOAD(c_) do { const int s0_ = (c_) * CH; \
            _Pragma("unroll") for (int i = 0; i < 4; ++i) { const int row = prow + 32 * i; \
                rq[i] = *(const u32x4*)(gQ + (size_t)(s0_ + row) * 1024 + pseg * 8); rk[i] = *(const u32x4*)(gK + (size_t)(s0_ + row) * 1024 + pseg * 8); \
                rkt[i] = *(const u32x4*)(gKT + (size_t)row * SEQ + s0_ + pseg * 8); } \
            rvt = *(const u32x4*)(gVT + (size_t)prow * SEQ + s0_ + pseg * 8); } while (0)
#define ML_LOADG(c_) do { rli = *(const f32x2*)(gLI + (c_) * CH + 2 * lane); rlf = *(const f32x2*)(gLF + (c_) * CH + 2 * lane); } while (0)
#define ML_SCALARS(sb_) do { LAS float* sA_ = (LAS float*)(lds + L_SC + (sb_) * (SC_FLOATS * 4)); \
            const float c1 = rlf[0] + rlf[1]; float incl = c1; \
            _Pragma("unroll") for (int o = 1; o < 64; o <<= 1) { const float t = __shfl_up(incl, o); if (lane >= o) incl += t; } \
            const float b1 = incl, b0 = incl - rlf[1]; const float a0 = rli[0] - b0, a1 = rli[1] - b1; float im = fmaxf(a0, a1); \
            _Pragma("unroll") for (int o = 1; o < 64; o <<= 1) { const float t = __shfl_up(im, o); if (lane >= o) im = fmaxf(im, t); } \
            float ex = __shfl_up(im, 1); if (lane == 0) ex = -INFINITY; \
            const float mx0 = fmaxf(m_prev, fmaxf(ex, a0)), mx1 = fmaxf(m_prev, im); const float mxl = __shfl(mx1, 63), bl = __shfl(b1, 63); \
            *(LAS f32x2*)(sA_ + 2 * lane) = (f32x2){a0, a1}; *(LAS f32x2*)(sA_ + 128 + 2 * lane) = (f32x2){mx0, mx1}; *(LAS f32x2*)(sA_ + 256 + 2 * lane) = (f32x2){b0, b1}; \
            *(LAS f32x2*)(sA_ + 384 + 2 * lane) = (f32x2){__expf(a0 - mxl), __expf(a1 - mxl)}; \
            if (lane == 0) { sA_[512] = m_prev; sA_[513] = mxl; sA_[514] = __expf(m_prev - mxl); } \
            m_prev = bl + mxl; } while (0)
        ML_LOAD(0);
        if (w == 0) { ML_LOADG(0); ML_SCALARS(0); ML_LOADG(1); }
        f32x4 accC[2][3];
#pragma unroll
        for (int dd = 0; dd < 2; ++dd)
#pragma unroll
            for (int e3 = 0; e3 < 3; ++e3) accC[dd][e3] = (f32x4){0.f, 0.f, 0.f, 0.f};
        for (int c = 0; c < NCHUNK; ++c) {
            const int sb = c & 1;
            LAS float* sA = (LAS float*)(lds + L_SC + sb * (SC_FLOATS * 4)); LAS float* sMx = sA + 128; LAS float* sB = sA + 256; LAS float* sWk = sA + 384; LAS float* sMisc = sA + 512;
            WG_BARRIER();
            {
                const f32x4 wk0 = *(const LAS f32x4*)(sWk + pseg * 8), wk1 = *(const LAS f32x4*)(sWk + pseg * 8 + 4);
#pragma unroll
                for (int i = 0; i < 4; ++i) { const int row = prow + 32 * i;
                    *(LAS u32x4*)(lds + L_Q + row * RS + pseg * 16) = rq[i]; *(LAS u32x4*)(lds + L_K + row * RS + pseg * 16) = rk[i];
                    const u32x4 v = rkt[i]; u32x4 o;
                    o.x = cvt_pk_bf16(bf_lo(v.x) * wk0[0], bf_hi(v.x) * wk0[1]); o.y = cvt_pk_bf16(bf_lo(v.y) * wk0[2], bf_hi(v.y) * wk0[3]);
                    o.z = cvt_pk_bf16(bf_lo(v.z) * wk1[0], bf_hi(v.z) * wk1[1]); o.w = cvt_pk_bf16(bf_lo(v.w) * wk1[2], bf_hi(v.w) * wk1[3]);
                    *(LAS u32x4*)(lds + L_KT + row * RS + pseg * 16) = o; }
                *(LAS u32x4*)(lds + L_VT + prow * RS + pseg * 16) = rvt;
            }
            WG_BARRIER_LDS();
            if (c + 1 < NCHUNK) ML_LOAD(c + 1);
            if (w == 0 && c + 1 < NCHUNK) { ML_SCALARS(sb ^ 1); if (c + 2 < NCHUNK) ML_LOADG(c + 2); }
            bf16x8 qf[4];
#pragma unroll
            for (int kk = 0; kk < 4; ++kk) qf[kk] = *(const LAS bf16x8*)(lds + L_Q + (16 * w + fr) * RS + (32 * kk + 8 * fq) * 2);
            f32x4 acc2[3] = {{0.f, 0.f, 0.f, 0.f}, {0.f, 0.f, 0.f, 0.f}, {0.f, 0.f, 0.f, 0.f}};
            const int ctb = L_CT + sb * 13056;
#pragma unroll
            for (int kk = 0; kk < 4; ++kk)
#pragma unroll
                for (int e3 = 0; e3 < 3; ++e3) { const bf16x8 cf = *(const LAS bf16x8*)(lds + ctb + (16 * e3 + fr) * RS + (32 * kk + 8 * fq) * 2);
                    acc2[e3] = __builtin_amdgcn_mfma_f32_16x16x32_bf16(qf[kk], cf, acc2[e3], 0, 0, 0); }
            const float mp = sMisc[0];
            const f32x4 mx4 = *(const LAS f32x4*)(sMx + 16 * w + 4 * fq), b4 = *(const LAS f32x4*)(sB + 16 * w + 4 * fq);
            {
                f32x4 wi;
#pragma unroll
                for (int j = 0; j < 4; ++j) wi[j] = __expf(mp - mx4[j]);
#pragma unroll
                for (int e3 = 0; e3 < 3; ++e3) acc2[e3] *= wi;
            }
            const int tl = 16 * w + fr; const float mxt = sMx[tl];
#pragma unroll
            for (int kk = 0; kk < 4; ++kk) {
                if (2 * kk <= w) {
                    unsigned pw[4] = {0u, 0u, 0u, 0u};
#pragma unroll
                    for (int h = 0; h < 2; ++h) { const int i = 2 * kk + h;
                        if (i <= w) { f32x4 sacc = {0.f, 0.f, 0.f, 0.f};
#pragma unroll
                            for (int k2 = 0; k2 < 4; ++k2) { const bf16x8 kf = *(const LAS bf16x8*)(lds + L_K + (16 * i + fr) * RS + (32 * k2 + 8 * fq) * 2);
                                sacc = __builtin_amdgcn_mfma_f32_16x16x32_bf16(kf, qf[k2], sacc, 0, 0, 0); }
                            const f32x4 av = *(const LAS f32x4*)(sA + 16 * i + 4 * fq); float pv[4];
#pragma unroll
                            for (int j = 0; j < 4; ++j) { const int sidx = 16 * i + 4 * fq + j; pv[j] = (sidx <= tl) ? sacc[j] * __expf(av[j] - mxt) : 0.f; }
                            pw[2 * h] = cvt_pk_bf16(pv[0], pv[1]); pw[2 * h + 1] = cvt_pk_bf16(pv[2], pv[3]); } }
                    const bf16x8 pf = __builtin_bit_cast(bf16x8, (u32x4){pw[0], pw[1], pw[2], pw[3]});
#pragma unroll
                    for (int e3 = 0; e3 < 3; ++e3) { const LAS unsigned char* vp = lds + L_VT + (16 * e3 + fr) * RS + (32 * kk + 4 * fq) * 2;
                        const u32x2 v0 = *(const LAS u32x2*)vp, v1 = *(const LAS u32x2*)(vp + 32);
                        const bf16x8 vf = __builtin_bit_cast(bf16x8, (u32x4){v0.x, v0.y, v1.x, v1.y});
                        acc2[e3] = __builtin_amdgcn_mfma_f32_16x16x32_bf16(pf, vf, acc2[e3], 0, 0, 0); }
                }
            }
            {
                const int s0 = c * CH;
#pragma unroll
                for (int j = 0; j < 4; ++j) { const float den = __shfl(acc2[2][j], lane & 48); const float thr = __expf(-(b4[j] + mx4[j]));
                    const float inv = 1.0f / fmaxf(fabsf(den), thr); bf16_t* hp = gH + (size_t)(s0 + 16 * w + 4 * fq + j) * DM + fr;
                    const unsigned hw = cvt_pk_bf16(acc2[0][j] * inv, acc2[1][j] * inv); hp[0] = (bf16_t)(hw & 0xffffu); hp[16] = (bf16_t)(hw >> 16); }
            }
            if (w < 4) {
                const float decay = sMisc[2];
                const int ctn = L_CT + (sb ^ 1) * 13056;
                bf16x8 vf[4][3];
#pragma unroll
                for (int kk = 0; kk < 4; ++kk)
#pragma unroll
                    for (int e3 = 0; e3 < 3; ++e3) vf[kk][e3] = *(const LAS bf16x8*)(lds + L_VT + (16 * e3 + fr) * RS + (32 * kk + 8 * fq) * 2);
#pragma unroll
                for (int dd = 0; dd < 2; ++dd) { const int dt = w + 4 * dd;
#pragma unroll
                    for (int e3 = 0; e3 < 3; ++e3) accC[dd][e3] *= decay;
#pragma unroll
                    for (int kk = 0; kk < 4; ++kk) { const bf16x8 kf = *(const LAS bf16x8*)(lds + L_KT + (16 * dt + fr) * RS + (32 * kk + 8 * fq) * 2);
#pragma unroll
                        for (int e3 = 0; e3 < 3; ++e3) accC[dd][e3] = __builtin_amdgcn_mfma_f32_16x16x32_bf16(kf, vf[kk][e3], accC[dd][e3], 0, 0, 0); }
#pragma unroll
                    for (int e3 = 0; e3 < 3; ++e3) { u32x2 o; o.x = cvt_pk_bf16(accC[dd][e3][0], accC[dd][e3][1]); o.y = cvt_pk_bf16(accC[dd][e3][2], accC[dd][e3][3]);
                        *(LAS u32x2*)(lds + ctn + (16 * e3 + fr) * RS + (16 * dt + 4 * fq) * 2) = o; } }
            }
        }
#undef ML_LOAD
#undef ML_LOADG
#undef ML_SCALARS
    }
    WG_BARRIER();
}

__device__ __forceinline__ void conv_item(const bf16_t* XB, const float* cw, const float* cb, bf16_t* XC, int idx) {
    const int r = idx >> 8, ch = (idx & 255) * 8, t = r & (SEQ - 1);
    u32x4 xv[4];
#pragma unroll
    for (int wv = 0; wv < 4; ++wv) { const int tt = t - 3 + wv; xv[wv] = (tt >= 0) ? *(const u32x4*)(XB + (size_t)(r - 3 + wv) * DM + ch) : (u32x4){0u, 0u, 0u, 0u}; }
    float acc[8];
    { const f32x4 b0 = *(const f32x4*)(cb + ch), b1 = *(const f32x4*)(cb + ch + 4);
#pragma unroll
      for (int j = 0; j < 4; ++j) { acc[j] = b0[j]; acc[4 + j] = b1[j]; } }
#pragma unroll
    for (int wv = 0; wv < 4; ++wv) { const f32x4 w0 = *(const f32x4*)(cw + wv * DM + ch), w1 = *(const f32x4*)(cw + wv * DM + ch + 4); const u32x4 x = xv[wv];
        acc[0] += w0[0] * bf_lo(x.x); acc[1] += w0[1] * bf_hi(x.x); acc[2] += w0[2] * bf_lo(x.y); acc[3] += w0[3] * bf_hi(x.y);
        acc[4] += w1[0] * bf_lo(x.z); acc[5] += w1[1] * bf_hi(x.z); acc[6] += w1[2] * bf_lo(x.w); acc[7] += w1[3] * bf_hi(x.w); }
    u32x4 o; o.x = cvt_pk_bf16(acc[0], acc[1]); o.y = cvt_pk_bf16(acc[2], acc[3]); o.z = cvt_pk_bf16(acc[4], acc[5]); o.w = cvt_pk_bf16(acc[6], acc[7]);
    *(u32x4*)(XC + (size_t)r * DM + ch) = o;
}
__device__ __forceinline__ void conv_phase(const bf16_t* XB, const float* cw, const float* cb, bf16_t* XC) {
    const int G = gridDim.x, rows_per = (MTOK + G - 1) / G, r0 = blockIdx.x * rows_per, r1 = min(MTOK, r0 + rows_per);
    const int tid = opaque_tid();
#pragma unroll 4
    for (int idx = r0 * 256 + tid; idx < r1 * 256; idx += 512) conv_item(XB, cw, cb, XC, idx);
}
__device__ __forceinline__ void scan1_phase(const unsigned* AU, float* PA, float* PH) {
    const int nth = gridDim.x * 512;
    for (int idx = blockIdx.x * 512 + opaque_tid(); idx < NBATCH * SCH * 1024; idx += nth) {
        const int ch = (idx & 1023) * 2, cc = (idx >> 10) & (SCH - 1), bb = idx >> 15;
        const size_t base = (size_t)(bb * SEQ + cc * SCL) * DM + ch;
        float h0 = 0.f, h1 = 0.f, p0 = 1.f, p1 = 1.f;
#pragma unroll 16
        for (int t = 0; t < SCL; ++t) { const u32x2 w = *(const u32x2*)(AU + base + (size_t)t * DM);
            const float a0 = 1.0f - bf_lo(w.x), a1 = 1.0f - bf_lo(w.y);
            h0 = a0 * h0 + bf_hi(w.x); h1 = a1 * h1 + bf_hi(w.y); p0 *= a0; p1 *= a1; }
        const size_t o = (size_t)(bb * SCH + cc) * DM + ch;
        *(f32x2*)(PA + o) = (f32x2){p0, p1}; *(f32x2*)(PH + o) = (f32x2){h0, h1};
    }
}
__device__ __forceinline__ void scan1_own_tiles(const unsigned* AU, float* PA, float* PH) {
    const int tid = opaque_tid();
    StaticOrder S; S.init(MTOK, 4096, gridDim.x, blockIdx.x);
    for (int i0 = 0; ; i0 += 4) {
        Unit u; const int ui = i0 + (tid >> 7);
        if (!S.next(i0, u)) break;
        if (S.next(ui, u)) {
            const int half = (tid >> 6) & 1, pair = tid & 63, ch = u.pn * 128 + 2 * pair;
            const int bb = u.pm >> 4, cc = (u.pm & 15) * 2 + half;
            const size_t base = (size_t)(u.pm * 256 + half * SCL) * DM + ch;
            float h0 = 0.f, h1 = 0.f, p0 = 1.f, p1 = 1.f;
#pragma unroll 16
            for (int t = 0; t < SCL; ++t) { const u32x2 w = *(const u32x2*)(AU + base + (size_t)t * DM);
                const float a0 = 1.0f - bf_lo(w.x), a1 = 1.0f - bf_lo(w.y);
                h0 = a0 * h0 + bf_hi(w.x); h1 = a1 * h1 + bf_hi(w.y); p0 *= a0; p1 *= a1; }
            const size_t o = (size_t)(bb * SCH + cc) * DM + ch;
            *(f32x2*)(PA + o) = (f32x2){p0, p1}; *(f32x2*)(PH + o) = (f32x2){h0, h1};
        }
    }
}
__device__ __forceinline__ void scan2_phase(const unsigned* AU, const float* PA, const float* PH, const bf16_t* GB, bf16_t* AB) {
    const int nth = gridDim.x * 512;
    for (int idx = blockIdx.x * 512 + opaque_tid(); idx < NBATCH * SCH * 1024; idx += nth) {
        const int ch = (idx & 1023) * 2, cc = (idx >> 10) & (SCH - 1), bb = idx >> 15;
        float h0 = 0.f, h1 = 0.f;
        for (int q = 0; q < cc; ++q) { const size_t o = (size_t)(bb * SCH + q) * DM + ch; const f32x2 pa = *(const f32x2*)(PA + o), ph = *(const f32x2*)(PH + o);
            h0 = pa[0] * h0 + ph[0]; h1 = pa[1] * h1 + ph[1]; }
        const size_t base = (size_t)(bb * SEQ + cc * SCL) * DM + ch;
#pragma unroll 16
        for (int t = 0; t < SCL; ++t) { const u32x2 w = *(const u32x2*)(AU + base + (size_t)t * DM);
            const unsigned g = *(const unsigned*)(GB + base + (size_t)t * DM);
            h0 = (1.0f - bf_lo(w.x)) * h0 + bf_hi(w.x); h1 = (1.0f - bf_lo(w.y)) * h1 + bf_hi(w.y);
            *(unsigned*)(AB + base + (size_t)t * DM) = cvt_pk_bf16(h0 * bf_lo(g), h1 * bf_hi(g)); }
    }
}

__device__ __forceinline__ void mlp_block(const Params& p, LAS unsigned char* lds, const XcdBarrier& xb, const int layer) {
    unsigned char* ws = p.ws;
    bf16_t* XR = (bf16_t*)(ws + OFF_XR);
    const float* MODp = (const float*)(ws + OFF_MOD);
    const float* mod = MODp + (layer * 2 + 1) * 4 * 6144;
    { EpiSqRelu e{(bf16_t*)(ws + SM_U)};
      gemm_phase(lds, (const bf16_t*)(ws + SM_HB), DM, (const bf16_t*)(ws + OFF_W_1) + (size_t)layer * DFF * DM, DM, MTOK, DFF, DM, 0, e); }
    xcd_barrier(xb);
    const bf16_t* A = (const bf16_t*)(ws + SM_U); const bf16_t* B = (const bf16_t*)(ws + OFF_W_2) + (size_t)layer * DFF * DM;
    unsigned* X = (unsigned*)(ws + OFF_XCH + (size_t)(layer == 0 ? 1 : 3) * SZ_XCH1); unsigned* cnt = (unsigned*)(ws + OFF_CNT) + (layer == 0 ? 1 : 3) * 64 * 64;
    if (layer == 0) {
        EpiResidNorm<false, false> e{XR, XR, mod + 4096, MODp + 2 * 4 * 6144, (bf16_t*)(ws + S1_HB), nullptr, nullptr, X, cnt};
        gemm_phase(lds, A, DFF, B, DFF, MTOK, DM, DFF, 0, e, 0);
        gemm_phase(lds, A, DFF, B, DFF, MTOK, DM, DFF, 0, e, 1);
        xcd_barrier(xb);
    } else {
        EpiResidNorm<false, true> e{XR, nullptr, mod + 4096, nullptr, nullptr, p.final_g, p.out, X, cnt};
        gemm_phase(lds, A, DFF, B, DFF, MTOK, DM, DFF, 0, e, 0);
        gemm_phase(lds, A, DFF, B, DFF, MTOK, DM, DFF, 0, e, 1);
    }
}
__global__ void __launch_bounds__(512) mega_fwd(Params p) {
    extern __shared__ __attribute__((aligned(16))) unsigned char smem[];
    LAS unsigned char* lds = (LAS unsigned char*)smem;
    unsigned char* ws = p.ws;
    if (ws == nullptr) cg::this_grid().sync();
    volatile LAS unsigned* xst = (volatile LAS unsigned*)(lds + L_XB);
    if (threadIdx.x < 4) xst[threadIdx.x] = 0u;
    __syncthreads();
    const XcdBarrier xb = xcd_barrier_post((unsigned*)(ws + OFF_BAR), xst);
    float* MOD = (float*)(ws + OFF_MOD);
    bf16_t* XR = (bf16_t*)(ws + OFF_XR);

    phase0(p, lds);
    xcd_barrier(xb);
    norm_phase<false>(p.x, MOD + 0 * 4 * 6144, (bf16_t*)(ws + S0_HB), nullptr, nullptr, (const unsigned long long*)(ws + OFF_MOD64), MOD);
    xcd_barrier(xb);
    gates_phase((const bf16_t*)(ws + S0_HB), (const bf16_t*)(ws + OFF_WG16), p.a_b_gate, (float*)(ws + OFF_LI), (float*)(ws + OFF_LF));
    { EpiProj e{(bf16_t*)(ws + S0_Q), (bf16_t*)(ws + S0_K), (bf16_t*)(ws + S0_KT), (bf16_t*)(ws + S0_VT), (bf16_t*)(ws + S0_O), 0};
      gemm_phase(lds, (const bf16_t*)(ws + S0_HB), DM, (const bf16_t*)(ws + OFF_W_AIN), DM, MTOK, 2048, DM, 0, e); }
    { EpiVT e{(bf16_t*)(ws + S0_VT)};
      gemm_phase(lds, (const bf16_t*)(ws + S0_HB), DM, (const bf16_t*)(ws + OFF_W_AIN) + (size_t)2048 * DM, DM, MTOK, 2048, DM, 0, e); }
    { EpiProj e{(bf16_t*)(ws + S0_Q), (bf16_t*)(ws + S0_K), (bf16_t*)(ws + S0_KT), (bf16_t*)(ws + S0_VT), (bf16_t*)(ws + S0_O), 16};
      gemm_phase(lds, (const bf16_t*)(ws + S0_HB), DM, (const bf16_t*)(ws + OFF_W_AIN) + (size_t)4096 * DM, DM, MTOK, 2048, DM, 0, e); }
    xcd_barrier(xb);
    mlstm_phase(lds, (const bf16_t*)(ws + S0_Q), (const bf16_t*)(ws + S0_K), (const bf16_t*)(ws + S0_KT), (const bf16_t*)(ws + S0_VT), (const float*)(ws + OFF_LI), (const float*)(ws + OFF_LF), (bf16_t*)(ws + S0_HH));
    xcd_barrier(xb);
    headnorm_phase((const bf16_t*)(ws + S0_HH), (const bf16_t*)(ws + S0_O), p.a_norm_g, (bf16_t*)(ws + S0_AB));
    xcd_barrier(xb);
    { EpiResidNorm<true, false> e{p.x, XR, MOD + 0 * 4 * 6144 + 4096, MOD + 1 * 4 * 6144, (bf16_t*)(ws + SM_HB), nullptr, nullptr, (unsigned*)(ws + OFF_XCH), (unsigned*)(ws + OFF_CNT)};
      gemm_phase(lds, (const bf16_t*)(ws + S0_AB), DM, (const bf16_t*)(ws + OFF_W_AOUT), DM, MTOK, DM, DM, 0, e, 0);
      gemm_phase(lds, (const bf16_t*)(ws + S0_AB), DM, (const bf16_t*)(ws + OFF_W_AOUT), DM, MTOK, DM, DM, 0, e, 1); }
    xcd_barrier(xb);
    mlp_block(p, lds, xb, 0);
    { EpiRgIn e{(bf16_t*)(ws + S1_XB), (bf16_t*)(ws + S1_GB)};
      gemm_phase(lds, (const bf16_t*)(ws + S1_HB), DM, (const bf16_t*)(ws + OFF_W_BIN), DM, MTOK, 4096, DM, 0, e); }
    xcd_barrier(xb);
    conv_phase((const bf16_t*)(ws + S1_XB), p.b_conv_w, p.b_conv_b, (bf16_t*)(ws + S1_XC));
    xcd_barrier(xb);
    { EpiGate e{(const bf16_t*)(ws + S1_XC), p.b_b_ra, p.b_b_ri, p.b_lam, (unsigned*)(ws + S1_A)};
      gemm_phase(lds, (const bf16_t*)(ws + S1_XC), DM, (const bf16_t*)(ws + OFF_W_GATE), 256, MTOK, 4096, 256, 1, e); }
    scan1_own_tiles((const unsigned*)(ws + S1_A), (float*)(ws + OFF_SCAN), (float*)(ws + OFF_SCAN) + NBATCH * SCH * DM);
    xcd_barrier(xb);
    scan2_phase((const unsigned*)(ws + S1_A), (const float*)(ws + OFF_SCAN), (const float*)(ws + OFF_SCAN) + NBATCH * SCH * DM, (const bf16_t*)(ws + S1_GB), (bf16_t*)(ws + S1_AB));
    xcd_barrier(xb);
    { EpiResidNorm<false, false> e{XR, XR, MOD + 2 * 4 * 6144 + 4096, MOD + 3 * 4 * 6144, (bf16_t*)(ws + SM_HB), nullptr, nullptr, (unsigned*)(ws + OFF_XCH + 2 * SZ_XCH1), (unsigned*)(ws + OFF_CNT) + 2 * 64 * 64};
      gemm_phase(lds, (const bf16_t*)(ws + S1_AB), DM, (const bf16_t*)(ws + OFF_W_BOUT), DM, MTOK, DM, DM, 0, e, 0);
      gemm_phase(lds, (const bf16_t*)(ws + S1_AB), DM, (const bf16_t*)(ws + OFF_W_BOUT), DM, MTOK, DM, DM, 0, e, 1); }
    xcd_barrier(xb);
    mlp_block(p, lds, xb, 1);

}

extern "C" void kernel_launch(void* const* d_in, const int* in_sizes, int n_in, void* d_out, int out_size, void* d_ws, size_t ws_size, hipStream_t stream) {
    static int grid_blocks = 0;
    if (grid_blocks == 0) {
        if (n_in != 20 || ws_size < WS_NEED) { fprintf(stderr, "kernel_launch: unexpected n_in %d or ws_size %zu (need %zu)\n", n_in, ws_size, (size_t)WS_NEED); grid_blocks = -1; return; }
        int dev = 0, cus = 0, per_cu = 0;
        (void)hipGetDevice(&dev);
        (void)hipDeviceGetAttribute(&cus, hipDeviceAttributeMultiprocessorCount, dev);
        if (hipFuncSetAttribute((const void*)mega_fwd, hipFuncAttributeMaxDynamicSharedMemorySize, LDS_BYTES) != hipSuccess) { fprintf(stderr, "kernel_launch: hipFuncSetAttribute failed\n"); }
        if (hipOccupancyMaxActiveBlocksPerMultiprocessor(&per_cu, (const void*)mega_fwd, 512, LDS_BYTES) != hipSuccess || per_cu < 1) { fprintf(stderr, "kernel_launch: occupancy query says %d\n", per_cu); per_cu = 1; }
        (void)hipGetLastError();
        grid_blocks = cus * per_cu;
    }
    if (grid_blocks < 0) return;
    (void)hipMemsetAsync((char*)d_ws + OFF_BAR, 0, 16384 + SZ_MOD64 + SZ_CNT, stream);
    Params p{};
    const float** pp = (const float**)&p;
    for (int i = 0; i < 20; ++i) pp[i] = (const float*)d_in[i];
    p.out = (float*)d_out; p.ws = (unsigned char*)d_ws;
    void* args[] = {&p};
    hipError_t e = hipLaunchCooperativeKernel((const void*)mega_fwd, dim3(grid_blocks), dim3(512), args, LDS_BYTES, stream);
    if (e != hipSuccess) fprintf(stderr, "cooperative launch failed: %s (grid %d)\n", hipGetErrorString(e), grid_blocks);
}
```

```cpp
#include <hip/hip_runtime.h>
#include <hip/hip_cooperative_groups.h>
#include <cstdio>
namespace cg = cooperative_groups;

#define LAS __attribute__((address_space(3)))
typedef unsigned short bf16_t;
typedef short bf16x8 __attribute__((ext_vector_type(8)));
typedef float f32x4 __attribute__((ext_vector_type(4)));
typedef float f32x2 __attribute__((ext_vector_type(2)));
typedef unsigned u32x4 __attribute__((ext_vector_type(4)));
typedef unsigned u32x2 __attribute__((ext_vector_type(2)));

constexpr int DM = 2048, NBATCH = 4, SEQ = 4096, MTOK = NBATCH * SEQ, DFF = 8192;
constexpr int NH = 8, DQK = 128, DV = 256, CH = 128, NCHUNK = SEQ / CH, INA = 6160;
constexpr int SCH = 32, SCL = SEQ / SCH;
constexpr float EPS = 1e-6f;

constexpr size_t OFF_MOD = 0;
constexpr size_t SZ_MOD = 4ull * 4 * 6144 * 4;
constexpr size_t OFF_BAR = OFF_MOD + SZ_MOD;
constexpr size_t SZ_BAR = 3456 * 4;
constexpr size_t OFF_MOD64 = OFF_BAR + 16384;
constexpr size_t SZ_MOD64 = 4ull * 4 * 6144 * 8;
constexpr size_t OFF_CNT = OFF_MOD64 + SZ_MOD64;
constexpr size_t SZ_CNT = 4ull * 64 * 256;
constexpr size_t OFF_WG16 = OFF_CNT + SZ_CNT;
constexpr size_t OFF_SCAN = OFF_WG16 + 16ull * 2048 * 2;
constexpr size_t OFF_LI = OFF_SCAN + 2ull * 4 * SCH * 2048 * 4;
constexpr size_t OFF_LF = OFF_LI + 4ull * 8 * 4096 * 4;
constexpr size_t OFF_XCH = OFF_LF + 4ull * 8 * 4096 * 4;
constexpr size_t SZ_XCH1 = 64ull * 256 * 8 * 4;
constexpr size_t OFF_W = 8ull << 20;
static_assert(OFF_XCH + 4 * SZ_XCH1 <= OFF_W, "ctl region");
constexpr size_t OFF_W_AIN = OFF_W;
constexpr size_t OFF_W_AOUT = OFF_W_AIN + 6144ull * 2048 * 2;
constexpr size_t OFF_W_BIN = OFF_W_AOUT + 2048ull * 2048 * 2;
constexpr size_t OFF_W_BOUT = OFF_W_BIN + 4096ull * 2048 * 2;
constexpr size_t OFF_W_GATE = OFF_W_BOUT + 2048ull * 2048 * 2;
constexpr size_t OFF_W_1 = OFF_W_GATE + 4096ull * 256 * 2;
constexpr size_t OFF_W_2 = OFF_W_1 + 2ull * 8192 * 2048 * 2;
constexpr size_t OFF_XR = OFF_W_2 + 2ull * 8192 * 2048 * 2;
constexpr size_t OFF_SCR = OFF_XR + (size_t)MTOK * DM * 4;
constexpr size_t SZ_ROWB = (size_t)MTOK * DM * 2;
constexpr size_t S0_HB = OFF_SCR, S0_Q = S0_HB + SZ_ROWB, S0_K = S0_Q + SZ_ROWB / 2, S0_KT = S0_K + SZ_ROWB / 2, S0_VT = S0_KT + SZ_ROWB / 2,
                 S0_O = S0_VT + SZ_ROWB, S0_HH = S0_O + SZ_ROWB, S0_END = S0_HH + 2 * SZ_ROWB, S0_AB = S0_HB;
constexpr size_t SM_U = OFF_SCR + SZ_ROWB, SM_HB = OFF_SCR + 5 * SZ_ROWB;
constexpr size_t S1_HB = OFF_SCR, S1_XB = S1_HB + SZ_ROWB, S1_GB = S1_XB + SZ_ROWB, S1_XC = S1_GB + SZ_ROWB, S1_A = S1_XC + SZ_ROWB  , S1_AB = S1_XC;
constexpr size_t WS_NEED = S0_END;

constexpr int L_XB = 148864;
constexpr int LDS_BYTES = L_XB + 64;

typedef __bf16 bf16x2_t __attribute__((ext_vector_type(2)));
__device__ __forceinline__ unsigned cvt_pk_bf16(float lo, float hi) { const bf16x2_t r = __builtin_convertvector((f32x2){lo, hi}, bf16x2_t); return __builtin_bit_cast(unsigned, r); }
__device__ __forceinline__ float bf_lo(unsigned w) { return __uint_as_float(w << 16); }
__device__ __forceinline__ float bf_hi(unsigned w) { return __uint_as_float(w & 0xffff0000u); }
__device__ __forceinline__ float wave_sum(float v) {
#pragma unroll
    for (int o = 1; o < 64; o <<= 1) v += __shfl_xor(v, o);
    return v;
}
__device__ __forceinline__ float sigmoidf_(float x) { return 1.0f / (1.0f + __expf(-x)); }
__device__ __forceinline__ int opaque_tid() { int t = threadIdx.x; asm volatile("" : "+v"(t)); return t; }
#define LDS_FENCE() asm volatile("s_waitcnt lgkmcnt(0)" ::: "memory")
#define WG_BARRIER() do { asm volatile("s_waitcnt vmcnt(0) lgkmcnt(0)" ::: "memory"); __builtin_amdgcn_s_barrier(); asm volatile("" ::: "memory"); } while (0)
#define WG_BARRIER_LDS() do { asm volatile("s_waitcnt lgkmcnt(0)" ::: "memory"); __builtin_amdgcn_s_barrier(); asm volatile("" ::: "memory"); } while (0)


#define XB_TMO      128
#define XB_XCNT(j)  (256  + 64 * (j))
#define XB_XSUB(j)  (1280 + 64 * (j))
#define XB_XGEN(j)  (2304 + 64 * (j))
#define XB_TOP      3328
#define XB_TOPGEN   3392
#define XB_SPIN_CAP (1u << 20)
__device__ __forceinline__ unsigned xb_ld(unsigned* p)              { return __hip_atomic_load(p, __ATOMIC_RELAXED, __HIP_MEMORY_SCOPE_AGENT); }
__device__ __forceinline__ unsigned xb_add(unsigned* p, unsigned v) { return __hip_atomic_fetch_add(p, v, __ATOMIC_RELAXED, __HIP_MEMORY_SCOPE_AGENT); }
__device__ __forceinline__ unsigned xb_xcc_id() { return (unsigned)__builtin_amdgcn_s_getreg((3 << 11) | 20) & 0xFu; }
#define XB_SPIN(cond, bar) do { unsigned _sp = 0; while (cond) { __builtin_amdgcn_s_sleep(1); \
    if ((++_sp & 255u) == 0u) { if (xb_ld(&(bar)[XB_TMO])) break; if (_sp > XB_SPIN_CAP) { atomicAdd(&(bar)[XB_TMO], 1u); break; } } } } while (0)
struct XcdBarrier { unsigned* bar; unsigned x; volatile LAS unsigned* st; };
__device__ __forceinline__ XcdBarrier xcd_barrier_post(unsigned* bar, volatile LAS unsigned* st) {
    XcdBarrier b; b.bar = bar; b.x = xb_xcc_id(); b.st = st;
    if (threadIdx.x == 0) (void)xb_add(&bar[XB_XCNT(b.x)], 1u);
    return b;
}
__device__ __forceinline__ void xcd_barrier_complete(unsigned* bar, unsigned x, unsigned& nloc, unsigned& nx) {
    const unsigned G = gridDim.x * gridDim.y * gridDim.z;
    unsigned sum, cnt, mine, sp = 0u;
    for (;;) {
        sum = 0u; cnt = 0u; mine = 0u;
#pragma unroll
        for (unsigned j = 0; j < 16; ++j) { const unsigned c = xb_ld(&bar[XB_XCNT(j)]); sum += c; cnt += (c > 0u) ? 1u : 0u; mine = (j == x) ? c : mine; }
        if (sum == G) break;
        __builtin_amdgcn_s_sleep(1);
        if ((++sp & 255u) == 0u) { if (xb_ld(&bar[XB_TMO])) break; if (sp > XB_SPIN_CAP) { atomicAdd(&bar[XB_TMO], 1u); break; } }
    }
    nloc = mine > 0u ? mine : 1u; nx = cnt > 0u ? cnt : 1u;
}
__device__ __forceinline__ void xcd_barrier(const XcdBarrier& b) {
    asm volatile("s_waitcnt vmcnt(0)" ::: "memory");
    __syncthreads();
    if (threadIdx.x == 0) {
        unsigned* bar = b.bar;
        __builtin_amdgcn_s_waitcnt(0);
        unsigned nloc = b.st[0], nx = b.st[1];
        if (nloc == 0u) { xcd_barrier_complete(bar, b.x, nloc, nx); b.st[0] = nloc; b.st[1] = nx; }
        const unsigned old = xb_add(&bar[XB_XSUB(b.x)], 1u);
        const unsigned gen = old / nloc;
        if (old + 1u == (gen + 1u) * nloc) {
            __builtin_amdgcn_fence(__ATOMIC_RELEASE, "agent");
            asm volatile("s_waitcnt vmcnt(0)" ::: "memory");
            const unsigned og = xb_add(&bar[XB_TOP], 1u);
            const unsigned tg = og / nx;
            if (og + 1u == (tg + 1u) * nx) xb_add(&bar[XB_TOPGEN], 1u);
            else XB_SPIN(xb_ld(&bar[XB_TOPGEN]) == tg, bar);
            __builtin_amdgcn_fence(__ATOMIC_ACQUIRE, "agent");
            xb_add(&bar[XB_XGEN(b.x)], 1u);
            asm volatile("s_waitcnt vmcnt(0)" ::: "memory");
        } else {
            XB_SPIN(xb_ld(&bar[XB_XGEN(b.x)]) == gen, bar);
            __builtin_amdgcn_fence(__ATOMIC_ACQUIRE, "agent");
            asm volatile("s_waitcnt vmcnt(0)" ::: "memory");
        }
    }
    __syncthreads();
}

struct Params {
    const float *x, *c, *ada_w, *ada_b, *a_w_in, *a_b_gate, *a_norm_g, *a_w_out, *b_w_in, *b_conv_w, *b_conv_b, *b_w_ra, *b_b_ra, *b_w_ri, *b_b_ri, *b_lam,
        *b_w_out, *mlp_w1, *mlp_w2, *final_g;
    float* out;
    unsigned char* ws;
};

constexpr int BM = 256, BK = 64, HALF = 128, HTB = HALF * BK * 2, NXCD = 8, WGM = 8;
__device__ __forceinline__ int lds_byte(int r, int c) { const int st = (r >> 4) * 2 + (c >> 5), rr = r & 15, cc = c & 31, ob = rr * 64 + cc * 2; return st * 1024 + (ob ^ (((ob >> 9) & 1) << 5)); }
__device__ __forceinline__ void stage_rc(int b, int& R, int& C) { const int st = b / 1024, sb = b % 1024, swz = sb ^ (((sb >> 9) & 1) << 5); R = (st >> 1) * 16 + swz / 64; C = (st & 1) * 32 + (swz % 64) / 2; }
__device__ __forceinline__ int perm32(int rho) { const int n = rho >> 4, i = rho & 15; return 8 * (i >> 2) + 4 * n + (i & 3); }
struct Unit { int pm, pn; };
struct StaticOrder {
    int nM, nN, nwg, G, c;
    __device__ void init(int M, int N, int G_, int c_) { nM = M / BM; nN = N / BM; nwg = nM * nN; G = G_; c = c_; }
    __device__ bool next(int i, Unit& u) const {
        const long L = (long)i * G + c; if (L >= nwg) return false;
        int wgid = (int)L; { const int q = nwg / NXCD, r = nwg % NXCD, xcd = wgid % NXCD, off = wgid / NXCD; wgid = (xcd < r ? xcd * (q + 1) : r * (q + 1) + (xcd - r) * q) + off; }
        const int nig = WGM * nN, gid = wgid / nig, fm = gid * WGM, gsz = (nM - fm) < WGM ? (nM - fm) : WGM;
        u.pm = fm + ((wgid % nig) % gsz); u.pn = (wgid % nig) / gsz; return true;
    }
};

template <class Epi>
__device__ __forceinline__ void gemm_phase(LAS unsigned char* lds, const bf16_t* A, int lda, const bf16_t* Bt, int ldb, int M, int N, int K, int asel, const Epi& E, const int fixed_round = -1) {
    const int tid = opaque_tid(), wid = __builtin_amdgcn_readfirstlane(tid >> 6), lane = tid & 63, wr = wid >> 2, wc = wid & 3, fr = lane & 15, fq = lane >> 4;
    const int nt = K / BK;
    constexpr bool NOSWAP = Epi::NOSWAP;
    StaticOrder S; S.init(M, N, gridDim.x, blockIdx.x);
    unsigned voffA[2], voffB[2];
#pragma unroll
    for (int i = 0; i < 2; ++i) { int R, C; stage_rc(tid * 16 + i * 8192, R, C); const int Rb = Epi::PERM ? ((R & ~31) + perm32(R & 31)) : R;
        voffA[i] = (unsigned)(R * lda + C) * 2u; voffB[i] = (unsigned)(Rb * ldb + C) * 2u; }
    const size_t kstep = (size_t)(BK * 2);
    const size_t hstepA = (size_t)HALF * lda * 2, hstepB = (size_t)HALF * ldb * 2;
    const size_t tstepA = 2 * hstepA, tstepB = 2 * hstepB;
    const unsigned ldsw = (unsigned)wid * 1024u;
    const int aoff = lds_byte(wr * 64 + fr, fq * 8), boff = lds_byte(wc * 32 + fr, fq * 8);
#define PG8_SA(b, h) (((b) * 2 + (h)) * HTB)
#define PG8_SB(b, h) ((4 + (b) * 2 + (h)) * HTB)
#define PG8_STAGE(bufoff, gbase, voff) do { _Pragma("unroll") for (int _i = 0; _i < 2; ++_i) \
        __builtin_amdgcn_global_load_lds((const unsigned*)((const char*)(gbase) + (voff)[_i]), (LAS unsigned*)(lds + (bufoff) + ldsw + _i * 8192), 16, 0, 0); } while (0)
#define PG8_LDA(dst, b, h) do { _Pragma("unroll") for (int m = 0; m < 4; ++m) _Pragma("unroll") for (int k = 0; k < 2; ++k) dst[m][k] = *(const LAS bf16x8*)(lds + PG8_SA(b, h) + aoff + m * 2048 + k * 1024); } while (0)
#define PG8_LDB(dst, b, h) do { _Pragma("unroll") for (int n = 0; n < 2; ++n) _Pragma("unroll") for (int k = 0; k < 2; ++k) dst[n][k] = *(const LAS bf16x8*)(lds + PG8_SB(b, h) + boff + n * 2048 + k * 1024); } while (0)
#define PG8_MMA(ai, bj, At, Bt_) do { __builtin_amdgcn_s_setprio(1); _Pragma("unroll") for (int m = 0; m < 4; ++m) _Pragma("unroll") for (int n = 0; n < 2; ++n) _Pragma("unroll") for (int k = 0; k < 2; ++k) \
        acc[ai][bj][m][n] = NOSWAP ? __builtin_amdgcn_mfma_f32_16x16x32_bf16(At[m][k], Bt_[n][k], acc[ai][bj][m][n], 0, 0, 0) : __builtin_amdgcn_mfma_f32_16x16x32_bf16(Bt_[n][k], At[m][k], acc[ai][bj][m][n], 0, 0, 0); __builtin_amdgcn_s_setprio(0); } while (0)
#define PG8_WAIT_V(n) asm volatile("s_waitcnt vmcnt(" #n ")" ::: "memory")
#define PG8_WAIT_L(n) asm volatile("s_waitcnt lgkmcnt(" #n ")" ::: "memory")
#define PG8_BAR __builtin_amdgcn_s_barrier()
#define PG8_SCHED __builtin_amdgcn_sched_barrier(0)
#define PG8_ABASE(u_) ((const char*)A + (size_t)(u_).pm * tstepA + (asel ? (size_t)((u_).pn >> 1) * 512 : (size_t)0))
    Unit cur, nxt; int ui = 0;
    if (fixed_round < 0) { if (!S.next(0, cur)) return; }
    else { const int c = blockIdx.x; cur.pm = 32 * fixed_round + 4 * (c & 7) + (c >> 6); cur.pn = (c >> 3) & 7; }
    f32x4 acc[2][2][4][2];
#pragma unroll
    for (int a = 0; a < 2; ++a)
#pragma unroll
        for (int b = 0; b < 2; ++b)
#pragma unroll
            for (int m = 0; m < 4; ++m)
#pragma unroll
                for (int n = 0; n < 2; ++n) acc[a][b][m][n] = (f32x4){0.f, 0.f, 0.f, 0.f};
    bf16x8 At[4][2], B0[2][2], B1[2][2];
    const char* cA = PG8_ABASE(cur); const char* cB = (const char*)Bt + (size_t)cur.pn * tstepB;
    PG8_STAGE(PG8_SB(0, 0), cB, voffB); PG8_STAGE(PG8_SA(0, 0), cA, voffA); PG8_STAGE(PG8_SB(0, 1), cB + hstepB, voffB); PG8_STAGE(PG8_SA(0, 1), cA + hstepA, voffA);
    if (wr == 1) PG8_BAR;
    PG8_WAIT_V(4); PG8_BAR;
    PG8_STAGE(PG8_SB(1, 0), cB + kstep, voffB); PG8_STAGE(PG8_SA(1, 0), cA + kstep, voffA); PG8_STAGE(PG8_SB(1, 1), cB + hstepB + kstep, voffB);
    PG8_WAIT_V(6); PG8_BAR;
    for (;;) {
        const bool has_next = (fixed_round < 0) && S.next(ui + 1, nxt);
        const char* nA = has_next ? PG8_ABASE(nxt) : cA; const char* nB = has_next ? (const char*)Bt + (size_t)nxt.pn * tstepB : cB;
        for (int t = 0; t < nt; t += 2) {
            const bool last = (t == nt - 2);
            const char* a1 = cA + (size_t)(t + 1) * kstep;
            const char* a2 = last ? nA : cA + (size_t)(t + 2) * kstep; const char* b2 = last ? nB : cB + (size_t)(t + 2) * kstep;
            const char* a3 = a2 + kstep; const char* b3 = b2 + kstep;
            PG8_LDB(B0, 0, 0); PG8_SCHED; PG8_LDA(At, 0, 0); PG8_STAGE(PG8_SA(1, 1), a1 + hstepA, voffA);
            PG8_WAIT_L(8); PG8_BAR; PG8_WAIT_L(0); PG8_MMA(0, 0, At, B0); PG8_BAR; PG8_SCHED;
            PG8_LDB(B1, 0, 1); PG8_STAGE(PG8_SB(0, 0), b2, voffB);
            PG8_BAR; PG8_WAIT_L(0); PG8_MMA(0, 1, At, B1); PG8_BAR;
            PG8_LDA(At, 0, 1); PG8_STAGE(PG8_SA(0, 0), a2, voffA);
            PG8_BAR; PG8_WAIT_L(0); PG8_MMA(1, 0, At, B0); PG8_BAR; PG8_SCHED;
            PG8_STAGE(PG8_SB(0, 1), b2 + hstepB, voffB);
            PG8_WAIT_V(6); PG8_BAR; PG8_MMA(1, 1, At, B1); PG8_BAR;
            PG8_LDB(B0, 1, 0); PG8_SCHED; PG8_LDA(At, 1, 0); PG8_STAGE(PG8_SA(0, 1), a2 + hstepA, voffA);
            PG8_WAIT_L(8); PG8_BAR; PG8_WAIT_L(0); PG8_MMA(0, 0, At, B0); PG8_BAR; PG8_SCHED;
            PG8_LDB(B1, 1, 1); PG8_STAGE(PG8_SB(1, 0), b3, voffB);
            PG8_BAR; PG8_WAIT_L(0); PG8_MMA(0, 1, At, B1); PG8_BAR;
            PG8_LDA(At, 1, 1); PG8_STAGE(PG8_SA(1, 0), a3, voffA);
            PG8_BAR; PG8_WAIT_L(0); PG8_MMA(1, 0, At, B0); PG8_BAR; PG8_SCHED;
            PG8_STAGE(PG8_SB(1, 1), b3 + hstepB, voffB);
            PG8_WAIT_V(6); PG8_BAR; PG8_MMA(1, 1, At, B1); PG8_BAR;
        }
        if constexpr (!Epi::AFTER_DRAIN) E(acc, cur, wr, wc, fr, fq);
        if (!has_next) break;
#pragma unroll
        for (int a = 0; a < 2; ++a)
#pragma unroll
            for (int b = 0; b < 2; ++b)
#pragma unroll
                for (int m = 0; m < 4; ++m)
#pragma unroll
                    for (int n = 0; n < 2; ++n) acc[a][b][m][n] = (f32x4){0.f, 0.f, 0.f, 0.f};
        cur = nxt; cA = nA; cB = nB; ++ui;
    }
    PG8_WAIT_V(0);
    if (wr == 0) PG8_BAR;
    PG8_BAR;
    if constexpr (Epi::AFTER_DRAIN) E.fused(acc, cur, wr, wc, fr, fq, lds);
#undef PG8_SA
#undef PG8_SB
#undef PG8_STAGE
#undef PG8_LDA
#undef PG8_LDB
#undef PG8_MMA
#undef PG8_WAIT_V
#undef PG8_WAIT_L
#undef PG8_BAR
#undef PG8_SCHED
#undef PG8_ABASE
}

typedef f32x4 AccT[2][2][4][2];

template <bool IN_F32>
struct EpiResid {
    static constexpr bool PERM = true, NOSWAP = false, AFTER_DRAIN = false;
    const void* Xin; bf16_t* Xout; const float* gate;
    __device__ __forceinline__ void operator()(const AccT& acc, const Unit& u, int wr, int wc, int fr, int fq) const {
        const int row0 = u.pm * BM + wr * 64 + fr, col0 = u.pn * BM + wc * 32 + 8 * fq;
        const float* g = gate + (u.pm >> 4) * 6144 + col0;
        f32x4 gv[2][2];
#pragma unroll
        for (int bj = 0; bj < 2; ++bj)
#pragma unroll
            for (int n = 0; n < 2; ++n) gv[bj][n] = *(const f32x4*)(g + bj * HALF + n * 4);
#pragma unroll
        for (int ai = 0; ai < 2; ++ai) {
            f32x4 xin[4][2][2];
#pragma unroll
            for (int m = 0; m < 4; ++m) { const size_t off = (size_t)(row0 + ai * HALF + m * 16) * DM + col0;
#pragma unroll
                for (int bj = 0; bj < 2; ++bj) {
                    if (IN_F32) { xin[m][bj][0] = *(const f32x4*)((const float*)Xin + off + bj * HALF); xin[m][bj][1] = *(const f32x4*)((const float*)Xin + off + bj * HALF + 4); }
                    else { const u32x4 w = *(const u32x4*)((const bf16_t*)Xin + off + bj * HALF);
                        xin[m][bj][0] = (f32x4){bf_lo(w.x), bf_hi(w.x), bf_lo(w.y), bf_hi(w.y)}; xin[m][bj][1] = (f32x4){bf_lo(w.z), bf_hi(w.z), bf_lo(w.w), bf_hi(w.w)}; } } }
            asm volatile("" ::: "memory");
#pragma unroll
            for (int m = 0; m < 4; ++m) { const size_t off = (size_t)(row0 + ai * HALF + m * 16) * DM + col0;
#pragma unroll
                for (int bj = 0; bj < 2; ++bj) { const f32x4 v0 = xin[m][bj][0] + gv[bj][0] * acc[ai][bj][m][0], v1 = xin[m][bj][1] + gv[bj][1] * acc[ai][bj][m][1];
                    u32x4 w; w.x = cvt_pk_bf16(v0[0], v0[1]); w.y = cvt_pk_bf16(v0[2], v0[3]); w.z = cvt_pk_bf16(v1[0], v1[1]); w.w = cvt_pk_bf16(v1[2], v1[3]);
                    *(u32x4*)(Xout + off + bj * HALF) = w; } }
            asm volatile("" ::: "memory");
        }
    }
};
template <bool IN_F32, bool FINAL>
struct EpiResidNorm {
    static constexpr bool PERM = true, NOSWAP = false, AFTER_DRAIN = true;
    const void* Xin; bf16_t* Xout; const float* gate; const float* modn; bf16_t* H; const float* fg; float* OUT; unsigned* X; unsigned* cnt;
    __device__ __forceinline__ void fused(AccT& acc, const Unit& u, int wr, int wc, int fr, int fq, LAS unsigned char* lds) const {
        const int tid = opaque_tid(), wid = tid >> 6, lane = tid & 63;
        const int row0 = u.pm * BM + wr * 64 + fr, col0 = u.pn * BM + wc * 32 + 8 * fq, bb = u.pm >> 4;
        LAS float* P = (LAS float*)lds; LAS float* Ssh = (LAS float*)(lds + 8192);
        {
            const float* g = gate + bb * 6144 + col0;
            f32x4 gv[2][2];
#pragma unroll
            for (int bj = 0; bj < 2; ++bj)
#pragma unroll
                for (int n = 0; n < 2; ++n) gv[bj][n] = *(const f32x4*)(g + bj * HALF + n * 4);
#pragma unroll
            for (int ai = 0; ai < 2; ++ai) {
                f32x4 xin[4][2][2];
#pragma unroll
                for (int m = 0; m < 4; ++m) { const size_t off = (size_t)(row0 + ai * HALF + m * 16) * DM + col0;
#pragma unroll
                    for (int bj = 0; bj < 2; ++bj) {
                        if (IN_F32) { xin[m][bj][0] = *(const f32x4*)((const float*)Xin + off + bj * HALF); xin[m][bj][1] = *(const f32x4*)((const float*)Xin + off + bj * HALF + 4); }
                        else { const u32x4 w = *(const u32x4*)((const bf16_t*)Xin + off + bj * HALF);
                            xin[m][bj][0] = (f32x4){bf_lo(w.x), bf_hi(w.x), bf_lo(w.y), bf_hi(w.y)}; xin[m][bj][1] = (f32x4){bf_lo(w.z), bf_hi(w.z), bf_lo(w.w), bf_hi(w.w)}; } } }
                asm volatile("" ::: "memory");
#pragma unroll
                for (int m = 0; m < 4; ++m) { const size_t off = (size_t)(row0 + ai * HALF + m * 16) * DM + col0;
#pragma unroll
                    for (int bj = 0; bj < 2; ++bj) { const f32x4 v0 = xin[m][bj][0] + gv[bj][0] * acc[ai][bj][m][0], v1 = xin[m][bj][1] + gv[bj][1] * acc[ai][bj][m][1];
                        u32x4 w; w.x = cvt_pk_bf16(v0[0], v0[1]); w.y = cvt_pk_bf16(v0[2], v0[3]); w.z = cvt_pk_bf16(v1[0], v1[1]); w.w = cvt_pk_bf16(v1[2], v1[3]);
                        if (!FINAL) *(u32x4*)(Xout + off + bj * HALF) = w;
                        acc[ai][bj][m][0] = (f32x4){bf_lo(w.x), bf_hi(w.x), bf_lo(w.y), bf_hi(w.y)}; acc[ai][bj][m][1] = (f32x4){bf_lo(w.z), bf_hi(w.z), bf_lo(w.w), bf_hi(w.w)}; } }
                asm volatile("" ::: "memory");
            }
        }
#pragma unroll
        for (int ai = 0; ai < 2; ++ai)
#pragma unroll
            for (int m = 0; m < 4; ++m) { float sq = 0.f;
#pragma unroll
                for (int bj = 0; bj < 2; ++bj)
#pragma unroll
                    for (int n = 0; n < 2; ++n) { const f32x4 x = acc[ai][bj][m][n]; sq += (x[0] * x[0] + x[1] * x[1]) + (x[2] * x[2] + x[3] * x[3]); }
                sq += __shfl_xor(sq, 16); sq += __shfl_xor(sq, 32);
                if (fq == 0) P[(ai * HALF + wr * 64 + m * 16 + fr) * 4 + wc] = sq; }
        WG_BARRIER_LDS();
        if (tid < 256) { const float t = (P[tid * 4] + P[tid * 4 + 1]) + (P[tid * 4 + 2] + P[tid * 4 + 3]);
            __hip_atomic_store(X + ((size_t)u.pm * 256 + tid) * 8 + u.pn, __float_as_uint(t), __ATOMIC_RELAXED, __HIP_MEMORY_SCOPE_AGENT); }
        asm volatile("s_waitcnt vmcnt(0)" ::: "memory");
        if (tid < 256 && lane == 0) __hip_atomic_fetch_add(cnt + 64 * u.pm, 1u, __ATOMIC_RELAXED, __HIP_MEMORY_SCOPE_AGENT);
        if (wid == 0) { unsigned spins = 0;
            while ((unsigned)__builtin_amdgcn_readfirstlane((int)__hip_atomic_load(cnt + 64 * u.pm, __ATOMIC_RELAXED, __HIP_MEMORY_SCOPE_AGENT)) < 32u) { __builtin_amdgcn_s_sleep(1); if (++spins > (1u << 22)) break; }
            __builtin_amdgcn_fence(__ATOMIC_ACQUIRE, "agent");
            asm volatile("s_waitcnt vmcnt(0)" ::: "memory"); }
        WG_BARRIER();
        if (tid < 256) { const unsigned* xp = X + ((size_t)u.pm * 256 + tid) * 8; float t = 0.f;
#pragma unroll
            for (int q = 0; q < 8; ++q) t += __uint_as_float(__hip_atomic_load(xp + q, __ATOMIC_RELAXED, __HIP_MEMORY_SCOPE_AGENT));
            Ssh[tid] = rsqrtf(t * (1.0f / DM) + EPS); }
        WG_BARRIER();
        f32x4 c0[2][2], c1[2][2];
#pragma unroll
        for (int bj = 0; bj < 2; ++bj)
#pragma unroll
            for (int n = 0; n < 2; ++n) { const int col = col0 + bj * HALF + n * 4;
                if (FINAL) { c0[bj][n] = *(const f32x4*)(fg + col); c1[bj][n] = (f32x4){0.f, 0.f, 0.f, 0.f}; }
                else { c0[bj][n] = *(const f32x4*)(modn + bb * 6144 + DM + col) + 1.0f; c1[bj][n] = *(const f32x4*)(modn + bb * 6144 + col); } }
#pragma unroll
        for (int ai = 0; ai < 2; ++ai)
#pragma unroll
            for (int m = 0; m < 4; ++m) { const int rl = ai * HALF + wr * 64 + m * 16 + fr; const float rstd = Ssh[rl]; const size_t off = (size_t)(row0 + ai * HALF + m * 16) * DM + col0;
#pragma unroll
                for (int bj = 0; bj < 2; ++bj) { const f32x4 o0 = acc[ai][bj][m][0] * rstd * c0[bj][0] + c1[bj][0], o1 = acc[ai][bj][m][1] * rstd * c0[bj][1] + c1[bj][1];
                    if (FINAL) { *(f32x4*)(OUT + off + bj * HALF) = o0; *(f32x4*)(OUT + off + bj * HALF + 4) = o1; }
                    else { u32x4 w; w.x = cvt_pk_bf16(o0[0], o0[1]); w.y = cvt_pk_bf16(o0[2], o0[3]); w.z = cvt_pk_bf16(o1[0], o1[1]); w.w = cvt_pk_bf16(o1[2], o1[3]);
                        *(u32x4*)(H + off + bj * HALF) = w; } } }
        WG_BARRIER_LDS();
    }
};
struct EpiSqRelu {
    static constexpr bool PERM = true, NOSWAP = false, AFTER_DRAIN = false;
    bf16_t* O;
    __device__ __forceinline__ void operator()(const AccT& acc, const Unit& u, int wr, int wc, int fr, int fq) const {
        const int row0 = u.pm * BM + wr * 64 + fr, col0 = u.pn * BM + wc * 32 + 8 * fq;
#pragma unroll
        for (int ai = 0; ai < 2; ++ai)
#pragma unroll
            for (int m = 0; m < 4; ++m) { bf16_t* rowp = O + (size_t)(row0 + ai * HALF + m * 16) * DFF + col0;
#pragma unroll
                for (int bj = 0; bj < 2; ++bj) { f32x4 v0 = acc[ai][bj][m][0], v1 = acc[ai][bj][m][1];
#pragma unroll
                    for (int j = 0; j < 4; ++j) { float a = fmaxf(v0[j], 0.f), b = fmaxf(v1[j], 0.f); v0[j] = a * a; v1[j] = b * b; }
                    u32x4 w; w.x = cvt_pk_bf16(v0[0], v0[1]); w.y = cvt_pk_bf16(v0[2], v0[3]); w.z = cvt_pk_bf16(v1[0], v1[1]); w.w = cvt_pk_bf16(v1[2], v1[3]);
                    *(u32x4*)(rowp + bj * HALF) = w; } }
    }
};
struct EpiProj {
    static constexpr bool PERM = true, NOSWAP = false, AFTER_DRAIN = false;
    bf16_t *Q, *Kn, *KT, *VT, *O; int pn_off;
    __device__ __forceinline__ void operator()(const AccT& acc, const Unit& u, int wr, int wc, int fr, int fq) const {
        const int row0 = u.pm * BM + wr * 64 + fr;
        const int pn = u.pn + pn_off;
        const int cl = wc * 32 + 8 * fq;
        if (pn < 8) {
            bf16_t* base = pn < 4 ? Q : Kn; const int colt = (pn & 3) * BM; const float sc = pn < 4 ? 0.08838834764831845f : 1.0f;
#pragma unroll
            for (int ai = 0; ai < 2; ++ai)
#pragma unroll
                for (int m = 0; m < 4; ++m) { bf16_t* rowp = base + (size_t)(row0 + ai * HALF + m * 16) * 1024 + colt + cl;
#pragma unroll
                    for (int bj = 0; bj < 2; ++bj) { const f32x4 v0 = acc[ai][bj][m][0] * sc, v1 = acc[ai][bj][m][1] * sc;
                        u32x4 w; w.x = cvt_pk_bf16(v0[0], v0[1]); w.y = cvt_pk_bf16(v0[2], v0[3]); w.z = cvt_pk_bf16(v1[0], v1[1]); w.w = cvt_pk_bf16(v1[2], v1[3]);
                        *(u32x4*)(rowp + bj * HALF) = w; } }
        }
        if (pn >= 16) {
            const int colt = (pn - 16) * BM;
#pragma unroll
            for (int ai = 0; ai < 2; ++ai)
#pragma unroll
                for (int m = 0; m < 4; ++m) { bf16_t* rowp = O + (size_t)(row0 + ai * HALF + m * 16) * DM + colt + cl;
#pragma unroll
                    for (int bj = 0; bj < 2; ++bj) { const f32x4 v0 = acc[ai][bj][m][0], v1 = acc[ai][bj][m][1];
                        u32x4 w; w.x = cvt_pk_bf16(v0[0], v0[1]); w.y = cvt_pk_bf16(v0[2], v0[3]); w.z = cvt_pk_bf16(v1[0], v1[1]); w.w = cvt_pk_bf16(v1[2], v1[3]);
                        *(u32x4*)(rowp + bj * HALF) = w; } }
        }
        if (pn >= 4 && pn < 16) {
            const bool isk = pn < 8;
            bf16_t* base = isk ? KT : VT;
            const int feat0 = (isk ? (pn - 4) : (pn - 8)) * BM;
            const int bb = u.pm >> 4; const int s0 = (u.pm & 15) * BM + wr * 64 + fr;
            const size_t bbase = (size_t)bb * (isk ? 1024 : 2048);
#pragma unroll
            for (int ai = 0; ai < 2; ++ai)
#pragma unroll
                for (int m = 0; m < 4; ++m) { const int s = s0 + ai * HALF + m * 16;
#pragma unroll
                    for (int bj = 0; bj < 2; ++bj)
#pragma unroll
                        for (int n = 0; n < 2; ++n)
#pragma unroll
                            for (int j = 0; j < 4; ++j) { const int feat = feat0 + bj * HALF + cl + 4 * n + j;
                                const unsigned w = cvt_pk_bf16(acc[ai][bj][m][n][j], 0.f);
                                base[(bbase + feat) * SEQ + s] = (bf16_t)(w & 0xffffu); } }
        }
    }
};
struct EpiVT {
    static constexpr bool PERM = false, NOSWAP = true, AFTER_DRAIN = false;
    bf16_t* VT;
    __device__ __forceinline__ void operator()(const AccT& acc, const Unit& u, int wr, int wc, int fr, int fq) const {
        const int bb = u.pm >> 4, s0 = (u.pm & 15) * BM + wr * 64 + 4 * fq, feat0 = u.pn * BM + wc * 32 + fr;
#pragma unroll
        for (int bj = 0; bj < 2; ++bj)
#pragma unroll
            for (int n = 0; n < 2; ++n) { bf16_t* fp = VT + ((size_t)bb * 2048 + feat0 + bj * HALF + n * 16) * SEQ + s0;
#pragma unroll
                for (int ai = 0; ai < 2; ++ai)
#pragma unroll
                    for (int m = 0; m < 4; ++m) { const f32x4 v = acc[ai][bj][m][n]; u32x2 w; w.x = cvt_pk_bf16(v[0], v[1]); w.y = cvt_pk_bf16(v[2], v[3]);
                        *(u32x2*)(fp + ai * HALF + m * 16) = w; } }
    }
};
struct EpiRgIn {
    static constexpr bool PERM = true, NOSWAP = false, AFTER_DRAIN = false;
    bf16_t *XB, *GB;
    __device__ __forceinline__ void operator()(const AccT& acc, const Unit& u, int wr, int wc, int fr, int fq) const {
        const int row0 = u.pm * BM + wr * 64 + fr; const bool isg = u.pn >= 8;
        bf16_t* base = isg ? GB : XB; const int col0 = (u.pn & 7) * BM + wc * 32 + 8 * fq;
#pragma unroll
        for (int ai = 0; ai < 2; ++ai)
#pragma unroll
            for (int m = 0; m < 4; ++m) { bf16_t* rowp = base + (size_t)(row0 + ai * HALF + m * 16) * DM + col0;
#pragma unroll
                for (int bj = 0; bj < 2; ++bj) { f32x4 v0 = acc[ai][bj][m][0], v1 = acc[ai][bj][m][1];
                    if (isg) {
#pragma unroll
                        for (int j = 0; j < 4; ++j) { float a = v0[j], b = v1[j];
                            const float ta = 1.5957691216057308f * (a + 0.044715f * a * a * a), tb = 1.5957691216057308f * (b + 0.044715f * b * b * b);
                            v0[j] = a * __builtin_amdgcn_rcpf(1.0f + __expf(-ta)); v1[j] = b * __builtin_amdgcn_rcpf(1.0f + __expf(-tb)); } }
                    u32x4 w; w.x = cvt_pk_bf16(v0[0], v0[1]); w.y = cvt_pk_bf16(v0[2], v0[3]); w.z = cvt_pk_bf16(v1[0], v1[1]); w.w = cvt_pk_bf16(v1[2], v1[3]);
                    *(u32x4*)(rowp + bj * HALF) = w; } }
    }
};
struct EpiGate {
    static constexpr bool PERM = false, NOSWAP = false, AFTER_DRAIN = false;
    const bf16_t* XC; const float *b_ra, *b_ri, *lam; unsigned* AU;
    __device__ __forceinline__ void operator()(const AccT& acc, const Unit& u, int wr, int wc, int fr, int fq) const {
        const int row0 = u.pm * BM + wr * 64 + fr, ch0 = u.pn * HALF + wc * 32 + 4 * fq;
#pragma unroll
        for (int n = 0; n < 2; ++n) {
            u32x2 xw[2][4];
#pragma unroll
            for (int ai = 0; ai < 2; ++ai)
#pragma unroll
                for (int m = 0; m < 4; ++m) xw[ai][m] = *(const u32x2*)(XC + (size_t)(row0 + ai * HALF + m * 16) * DM + ch0 + 16 * n);
            const f32x4 bra = *(const f32x4*)(b_ra + ch0 + 16 * n), bri = *(const f32x4*)(b_ri + ch0 + 16 * n), l = *(const f32x4*)(lam + ch0 + 16 * n);
            f32x4 sp;
#pragma unroll
            for (int j = 0; j < 4; ++j) sp[j] = -8.0f * log1pf(__expf(-l[j]));
#pragma unroll
            for (int ai = 0; ai < 2; ++ai)
#pragma unroll
                for (int m = 0; m < 4; ++m) { const size_t off = (size_t)(row0 + ai * HALF + m * 16) * DM + ch0 + 16 * n;
                    const f32x4 rp = acc[ai][0][m][n] + bra, ip = acc[ai][1][m][n] + bri;
                    const u32x2 w = xw[ai][m]; const float xv[4] = {bf_lo(w.x), bf_hi(w.x), bf_lo(w.y), bf_hi(w.y)};
                    u32x4 o;
#pragma unroll
                    for (int j = 0; j < 4; ++j) { const float r = __builtin_amdgcn_rcpf(1.0f + __expf(-rp[j])), ig = __builtin_amdgcn_rcpf(1.0f + __expf(-ip[j])); const float la = sp[j] * r; const float d = 1.0f - __expf(la);
                        o[j] = cvt_pk_bf16(d, __builtin_amdgcn_sqrtf(fmaxf(d * (2.0f - d), 0.f)) * (ig * xv[j])); }
                    *(u32x4*)(AU + off) = o; }
        }
    }
};

__device__ __forceinline__ void transpose_item(const float* src, int ldsrc, bf16_t* dst, int lddst, int kt, int ntile, LAS float* scr, int lane) {
    const int k0 = kt * 64, n0 = ntile * 64, l16 = lane & 15, l4 = lane >> 4;
    f32x4 tv[16];
#pragma unroll
    for (int i = 0; i < 16; ++i) tv[i] = *(const f32x4*)(src + (size_t)(k0 + l4 + 4 * i) * ldsrc + n0 + 4 * l16);
#pragma unroll
    for (int i = 0; i < 16; ++i) { const int kk = l4 + 4 * i; const f32x4 v = tv[i];
        LAS float* d = scr + kk * 65 + 4 * l16; d[0] = v[0]; d[1] = v[1]; d[2] = v[2]; d[3] = v[3]; }
    LDS_FENCE();
    const int c = lane & 7;
#pragma unroll
    for (int j = 0; j < 8; ++j) { const int n = (lane >> 3) + 8 * j; const LAS float* s = scr + (8 * c) * 65 + n;
        u32x4 o; o.x = cvt_pk_bf16(s[0], s[65]); o.y = cvt_pk_bf16(s[2 * 65], s[3 * 65]); o.z = cvt_pk_bf16(s[4 * 65], s[5 * 65]); o.w = cvt_pk_bf16(s[6 * 65], s[7 * 65]);
        *(u32x4*)(dst + (size_t)(n0 + n) * lddst + k0 + 8 * c) = o; }
    LDS_FENCE();
}
__device__ __forceinline__ void gemv_item(const Params& p, unsigned long long* MOD, int it, LAS float* scr, int lane) {
    const int mat = it / 1536, rem = it % 1536, cb = rem >> 6, ks = rem & 63, k0 = ks * 32, n0 = cb * 256 + 4 * lane;
#pragma unroll
    for (int i = 0; i < 2; ++i) { const int idx = lane + 64 * i, b = idx >> 5, kk = idx & 31; const float cv = p.c[b * DM + k0 + kk]; scr[idx] = cv / (1.0f + __expf(-cv)); }
    LDS_FENCE();
    const float* W = p.ada_w + (size_t)mat * DM * 6144 + (size_t)k0 * 6144 + n0;
    f32x4 a0 = {0, 0, 0, 0}, a1 = a0, a2 = a0, a3 = a0;
#pragma unroll 16
    for (int kk = 0; kk < 32; ++kk) { const f32x4 w = *(const f32x4*)(W + (size_t)kk * 6144);
        a0 += w * scr[kk]; a1 += w * scr[32 + kk]; a2 += w * scr[64 + kk]; a3 += w * scr[96 + kk]; }
    if (ks == 0) { const f32x4 bv = *(const f32x4*)(p.ada_b + mat * 6144 + n0); a0 += bv; a1 += bv; a2 += bv; a3 += bv; }
    unsigned long long* o = MOD + (size_t)mat * 4 * 6144 + n0;
#pragma unroll
    for (int j = 0; j < 4; ++j) { atomicAdd(o + j, (unsigned long long)__float2ll_rn(a0[j] * 1099511627776.0f)); atomicAdd(o + 6144 + j, (unsigned long long)__float2ll_rn(a1[j] * 1099511627776.0f));
        atomicAdd(o + 2 * 6144 + j, (unsigned long long)__float2ll_rn(a2[j] * 1099511627776.0f)); atomicAdd(o + 3 * 6144 + j, (unsigned long long)__float2ll_rn(a3[j] * 1099511627776.0f)); }
    LDS_FENCE();
}
__device__ __forceinline__ void phase0(const Params& p, LAS unsigned char* lds, const bool do_gemv = true) {
    const int tid = opaque_tid(), lane = tid & 63, wave = __builtin_amdgcn_readfirstlane(tid >> 6);
    const int G = gridDim.x, gw = blockIdx.x * 8 + wave, NGW = G * 8;
    LAS float* scr = (LAS float*)(lds + wave * 16640);
    unsigned char* ws = p.ws;
    { bf16_t* WG16 = (bf16_t*)(ws + OFF_WG16);
      for (int idx = blockIdx.x * 512 + tid; idx < 16 * 2048; idx += G * 512) { const int g = idx & 15, k = idx >> 4;
          const unsigned w = cvt_pk_bf16(p.a_w_in[(size_t)k * INA + 6144 + g], 0.f); WG16[g * 2048 + k] = (bf16_t)(w & 0xffffu); } }
    constexpr int I_GEMV = 6144, I_AIN = 32 * 96, I_SQ = 32 * 32, I_BIN = 32 * 64, I_MLP = 32 * 128, I_GATE = 256;
    constexpr int NITEMS = I_GEMV + I_AIN + 2 * I_SQ + I_BIN + 4 * I_MLP + I_GATE;
    unsigned long long* MOD = (unsigned long long*)(ws + OFF_MOD64);
    for (int it = gw; it < NITEMS; it += NGW) {
        int r = it;
        if (r < I_GEMV) { if (do_gemv) gemv_item(p, MOD, r, scr, lane); continue; } r -= I_GEMV;
        if (r < I_AIN) { transpose_item(p.a_w_in, INA, (bf16_t*)(ws + OFF_W_AIN), 2048, r / 96, r % 96, scr, lane); continue; } r -= I_AIN;
        if (r < I_SQ) { transpose_item(p.a_w_out, 2048, (bf16_t*)(ws + OFF_W_AOUT), 2048, r / 32, r % 32, scr, lane); continue; } r -= I_SQ;
        if (r < I_SQ) { transpose_item(p.b_w_out, 2048, (bf16_t*)(ws + OFF_W_BOUT), 2048, r / 32, r % 32, scr, lane); continue; } r -= I_SQ;
        if (r < I_BIN) { transpose_item(p.b_w_in, 4096, (bf16_t*)(ws + OFF_W_BIN), 2048, r / 64, r % 64, scr, lane); continue; } r -= I_BIN;
        if (r < 2 * I_MLP) { const int l = r / I_MLP, q = r % I_MLP; transpose_item(p.mlp_w1 + (size_t)l * DM * DFF, DFF, (bf16_t*)(ws + OFF_W_1) + (size_t)l * DFF * DM, DM, q / 128, q % 128, scr, lane); continue; } r -= 2 * I_MLP;
        if (r < 2 * I_MLP) { const int l = r / I_MLP, q = r % I_MLP; transpose_item(p.mlp_w2 + (size_t)l * DM * DFF, DM, (bf16_t*)(ws + OFF_W_2) + (size_t)l * DFF * DM, DFF, q / 32, q % 32, scr, lane); continue; } r -= 2 * I_MLP;
        { const int sub = r >> 3, q = r & 7, kt = q >> 1, ntile = q & 1, nb = sub >> 2, gate = (sub >> 1) & 1, dh = sub & 1;
          const float* src = (gate ? p.b_w_ri : p.b_w_ra) + (size_t)nb * 65536 + dh * 128;
          bf16_t* dst = (bf16_t*)(ws + OFF_W_GATE) + (size_t)((nb * 2 + dh) * 256 + gate * 128) * 256;
          transpose_item(src, 256, dst, 256, kt, ntile, scr, lane); }
    }
}

__device__ __forceinline__ f32x4 ld_fx4(const unsigned long long* p) {
    const long long a = (long long)p[0], b = (long long)p[1], c = (long long)p[2], d = (long long)p[3];
    return (f32x4){(float)a, (float)b, (float)c, (float)d} * 9.094947017729282e-13f;
}
template <bool FINAL>
__device__ __forceinline__ void norm_phase(const float* X, const float* mod, bf16_t* H, const float* fg, float* OUT, const unsigned long long* acc64 = nullptr, float* modf = nullptr) {
    const int tid = opaque_tid(), lane = tid & 63, wave = tid >> 6;
    const int gw = blockIdx.x * 8 + wave, NGW = gridDim.x * 8;
    if (acc64) for (int i = blockIdx.x * 512 + tid; i < 4 * 4 * 6144; i += gridDim.x * 512) modf[i] = (float)(long long)acc64[i] * 9.094947017729282e-13f;
    for (int r = gw; r < MTOK; r += NGW) {
        const f32x4* xr = (const f32x4*)(X + (size_t)r * DM) + lane;
        f32x4 v[8]; float ss = 0.f;
#pragma unroll
        for (int j = 0; j < 8; ++j) { v[j] = xr[64 * j]; ss += (v[j][0] * v[j][0] + v[j][1] * v[j][1]) + (v[j][2] * v[j][2] + v[j][3] * v[j][3]); }
        const float rstd = rsqrtf(wave_sum(ss) * (1.0f / DM) + EPS);
        if (FINAL) {
#pragma unroll
            for (int j = 0; j < 8; ++j) { const f32x4 g = *((const f32x4*)fg + lane + 64 * j); *((f32x4*)(OUT + (size_t)r * DM) + lane + 64 * j) = v[j] * rstd * g; }
        } else {
            const float* mb = mod + (r >> 12) * 6144; const unsigned long long* mb64 = acc64 + (r >> 12) * 6144;
#pragma unroll
            for (int j = 0; j < 8; ++j) { const f32x4 sh = acc64 ? ld_fx4(mb64 + 4 * (lane + 64 * j)) : *((const f32x4*)mb + lane + 64 * j), sc = acc64 ? ld_fx4(mb64 + DM + 4 * (lane + 64 * j)) : *((const f32x4*)(mb + DM) + lane + 64 * j);
                const f32x4 o = v[j] * rstd * (sc + 1.0f) + sh; u32x2 w; w.x = cvt_pk_bf16(o[0], o[1]); w.y = cvt_pk_bf16(o[2], o[3]);
                *((u32x2*)(H + (size_t)r * DM) + lane + 64 * j) = w; }
        }
    }
}
template <bool FINAL>
__device__ __forceinline__ void norm_phase_b(const bf16_t* X, const float* mod, bf16_t* H, const float* fg, float* OUT) {
    const int tid = opaque_tid(), lane = tid & 63, wave = tid >> 6;
    const int gw = blockIdx.x * 8 + wave, NGW = gridDim.x * 8;
    for (int rb = gw; rb < MTOK / 2; rb += NGW) {
        u32x4 raw[2][4];
#pragma unroll
        for (int q = 0; q < 2; ++q)
#pragma unroll
            for (int j = 0; j < 4; ++j) raw[q][j] = *((const u32x4*)(X + (size_t)(2 * rb + q) * DM) + lane + 64 * j);
#pragma unroll
        for (int q = 0; q < 2; ++q) {
            const int r = 2 * rb + q;
            f32x4 v[4][2]; float ss = 0.f;
#pragma unroll
            for (int j = 0; j < 4; ++j) { const u32x4 w = raw[q][j];
                v[j][0] = (f32x4){bf_lo(w.x), bf_hi(w.x), bf_lo(w.y), bf_hi(w.y)}; v[j][1] = (f32x4){bf_lo(w.z), bf_hi(w.z), bf_lo(w.w), bf_hi(w.w)};
#pragma unroll
                for (int h = 0; h < 2; ++h) ss += (v[j][h][0] * v[j][h][0] + v[j][h][1] * v[j][h][1]) + (v[j][h][2] * v[j][h][2] + v[j][h][3] * v[j][h][3]); }
            const float rstd = rsqrtf(wave_sum(ss) * (1.0f / DM) + EPS);
            if (FINAL) {
#pragma unroll
                for (int j = 0; j < 4; ++j)
#pragma unroll
                    for (int h = 0; h < 2; ++h) { const int col = 8 * lane + 512 * j + 4 * h; const f32x4 g = *(const f32x4*)(fg + col); *(f32x4*)(OUT + (size_t)r * DM + col) = v[j][h] * rstd * g; }
            } else {
                const float* mb = mod + (r >> 12) * 6144;
#pragma unroll
                for (int j = 0; j < 4; ++j) { f32x4 o[2];
#pragma unroll
                    for (int h = 0; h < 2; ++h) { const int col = 8 * lane + 512 * j + 4 * h; const f32x4 sh = *(const f32x4*)(mb + col), sc = *(const f32x4*)(mb + DM + col); o[h] = v[j][h] * rstd * (sc + 1.0f) + sh; }
                    u32x4 w; w.x = cvt_pk_bf16(o[0][0], o[0][1]); w.y = cvt_pk_bf16(o[0][2], o[0][3]); w.z = cvt_pk_bf16(o[1][0], o[1][1]); w.w = cvt_pk_bf16(o[1][2], o[1][3]);
                    *((u32x4*)(H + (size_t)r * DM) + lane + 64 * j) = w; }
            }
        }
    }
}
__device__ __forceinline__ void headnorm_phase(const bf16_t* HH, const bf16_t* O, const float* ng, bf16_t* AB) {
    const int tid = opaque_tid(), lane = tid & 63, wave = tid >> 6;
    const int gw = blockIdx.x * 8 + wave, NGW = gridDim.x * 8;
    for (int r = gw; r < MTOK; r += NGW) {
        const u32x4* xr = (const u32x4*)(HH + (size_t)r * DM) + lane; const u32x4* orow = (const u32x4*)(O + (size_t)r * DM) + lane;
        u32x4 hv[4], ov[4];
#pragma unroll
        for (int j = 0; j < 4; ++j) { hv[j] = xr[64 * j]; ov[j] = orow[64 * j]; }
#pragma unroll
        for (int j = 0; j < 4; ++j) {
            const f32x4 v0 = {bf_lo(hv[j].x), bf_hi(hv[j].x), bf_lo(hv[j].y), bf_hi(hv[j].y)}, v1 = {bf_lo(hv[j].z), bf_hi(hv[j].z), bf_lo(hv[j].w), bf_hi(hv[j].w)};
            float ss = (v0[0] * v0[0] + v0[1] * v0[1]) + (v0[2] * v0[2] + v0[3] * v0[3]) + (v1[0] * v1[0] + v1[1] * v1[1]) + (v1[2] * v1[2] + v1[3] * v1[3]);
#pragma unroll
            for (int o = 1; o < 32; o <<= 1) ss += __shfl_xor(ss, o);
            const float rs = rsqrtf(ss * (1.0f / DV) + EPS);
            const int col = 8 * lane + 512 * j; const f32x4 g0 = *(const f32x4*)(ng + col), g1 = *(const f32x4*)(ng + col + 4);
            const f32x4 o0 = {bf_lo(ov[j].x), bf_hi(ov[j].x), bf_lo(ov[j].y), bf_hi(ov[j].y)}, o1 = {bf_lo(ov[j].z), bf_hi(ov[j].z), bf_lo(ov[j].w), bf_hi(ov[j].w)};
            f32x4 r0, r1;
#pragma unroll
            for (int q = 0; q < 4; ++q) { r0[q] = v0[q] * rs * g0[q] * sigmoidf_(o0[q]); r1[q] = v1[q] * rs * g1[q] * sigmoidf_(o1[q]); }
            u32x4 w; w.x = cvt_pk_bf16(r0[0], r0[1]); w.y = cvt_pk_bf16(r0[2], r0[3]); w.z = cvt_pk_bf16(r1[0], r1[1]); w.w = cvt_pk_bf16(r1[2], r1[3]);
            *((u32x4*)(AB + (size_t)r * DM) + lane + 64 * j) = w; }
    }
}

__device__ __forceinline__ float log_sigmoidf_(float x) { return fminf(x, 0.f) - log1pf(__expf(-fabsf(x))); }
__device__ __forceinline__ void gates_phase(const bf16_t* HB, const bf16_t* WG16, const float* bg, float* LI, float* LF) {
    const int tid = opaque_tid(), lane = tid & 63, wave = tid >> 6, fr = lane & 15, fq = lane >> 4;
    for (int rt = wave * gridDim.x + blockIdx.x; rt < MTOK / 16; rt += 8 * gridDim.x) {
        const bf16_t* ap = HB + (size_t)(rt * 16 + fr) * DM + 8 * fq; const bf16_t* bp = WG16 + fr * DM + 8 * fq;
        f32x4 acc = {0.f, 0.f, 0.f, 0.f};
#pragma unroll 16
        for (int kk = 0; kk < 64; ++kk) { const bf16x8 a = *(const bf16x8*)(ap + 32 * kk), b = *(const bf16x8*)(bp + 32 * kk);
            acc = __builtin_amdgcn_mfma_f32_16x16x32_bf16(a, b, acc, 0, 0, 0); }
        const int r0 = rt * 16 + 4 * fq, bb = r0 >> 12, s = r0 & 4095, g = fr & 7;
        const float bias = bg[fr];
        f32x4 o;
        if (fr < 8) { o = acc + bias; *(f32x4*)(LI + (size_t)(bb * 8 + g) * SEQ + s) = o; }
        else {
#pragma unroll
            for (int j = 0; j < 4; ++j) o[j] = log_sigmoidf_(acc[j] + bias);
            *(f32x4*)(LF + (size_t)(bb * 8 + g) * SEQ + s) = o; }
    }
}

constexpr int RS = 272;
constexpr int L_Q = 0, L_K = 34816, L_KT = 69632, L_VT = 104448, L_CT = 117504  , L_SC = 143616  ;
constexpr int SC_FLOATS = 656;
__device__ __forceinline__ void mlstm_phase(LAS unsigned char* lds, const bf16_t* Q, const bf16_t* Kn, const bf16_t* KT, const bf16_t* VT, const float* LI, const float* LF, bf16_t* HH) {
    const int tid = opaque_tid(), lane = tid & 63, w = __builtin_amdgcn_readfirstlane(tid >> 6), fr = lane & 15, fq = lane >> 4;
    for (int item = blockIdx.x; item < NBATCH * NH * 8; item += gridDim.x) {
        const int xcd = item & 7, slot = item >> 3, eb = slot & 7, bh = xcd * 4 + (slot >> 3), hh = bh & 7, bb = bh >> 3;
        WG_BARRIER();
        for (int i = tid; i < 2 * 13056 / 4; i += 512) *(LAS unsigned*)(lds + L_CT + 4 * i) = 0u;
        for (int i = tid; i < 16 * RS / 4; i += 512) *(LAS unsigned*)(lds + L_VT + 32 * RS + 4 * i) = (i < RS / 4) ? 0x3F803F80u : 0u;
        const bf16_t* gQ = Q + (size_t)bb * SEQ * 1024 + hh * 128;
        const bf16_t* gK = Kn + (size_t)bb * SEQ * 1024 + hh * 128;
        const bf16_t* gKT = KT + (size_t)(bb * 8 + hh) * 128 * SEQ;
        const bf16_t* gVT = VT + ((size_t)(bb * 8 + hh) * 256 + eb * 32) * SEQ;
        const float* gLI = LI + (size_t)(bb * 8 + hh) * SEQ; const float* gLF = LF + (size_t)(bb * 8 + hh) * SEQ;
        bf16_t* gH = HH + (size_t)bb * SEQ * DM + hh * 256 + eb * 32;
        u32x4 rq[4], rk[4], rkt[4], rvt; f32x2 rli = {0.f, 0.f}, rlf = {0.f, 0.f};
        const int prow = tid >> 4, pseg = tid & 15;
        float m_prev = 0.f;
#define ML_LOAD(c_) do { const int s0_ = (c_) * CH; \
            _Pragma("unroll") for (int i = 0; i < 4; ++i) { const int row = prow + 32 * i; \
                rq[i] = *(const u32x4*)(gQ + (size_t)(s0_ + row) * 1024 + pseg * 8); rk[i] = *(const u32x4*)(gK + (size_t)(s0_ + row) * 1024 + pseg * 8); \
                rkt[i] = *(const u32x4*)(gKT + (size_t)row * SEQ + s0_ + pseg * 8); } \
            rvt = *(const u32x4*)(gVT + (size_t)prow * SEQ + s0_ + pseg * 8); } while (0)
#define ML_LOADG(c_) do { rli = *(const f32x2*)(gLI + (c_) * CH + 2 * lane); rlf = *(const f32x2*)(gLF + (c_) * CH + 2 * lane); } while (0)
#define ML_SCALARS(sb_) do { LAS float* sA_ = (LAS float*)(lds + L_SC + (sb_) * (SC_FLOATS * 4)); \
            const float c1 = rlf[0] + rlf[1]; float incl = c1; \
            _Pragma("unroll") for (int o = 1; o < 64; o <<= 1) { const float t = __shfl_up(incl, o); if (lane >= o) incl += t; } \
            const float b1 = incl, b0 = incl - rlf[1]; const float a0 = rli[0] - b0, a1 = rli[1] - b1; float im = fmaxf(a0, a1); \
            _Pragma("unroll") for (int o = 1; o < 64; o <<= 1) { const float t = __shfl_up(im, o); if (lane >= o) im = fmaxf(im, t); } \
            float ex = __shfl_up(im, 1); if (lane == 0) ex = -INFINITY; \
            const float mx0 = fmaxf(m_prev, fmaxf(ex, a0)), mx1 = fmaxf(m_prev, im); const float mxl = __shfl(mx1, 63), bl = __shfl(b1, 63); \
            *(LAS f32x2*)(sA_ + 2 * lane) = (f32x2){a0, a1}; *(LAS f32x2*)(sA_ + 128 + 2 * lane) = (f32x2){mx0, mx1}; *(LAS f32x2*)(sA_ + 256 + 2 * lane) = (f32x2){b0, b1}; \
            *(LAS f32x2*)(sA_ + 384 + 2 * lane) = (f32x2){__expf(a0 - mxl), __expf(a1 - mxl)}; \
            if (lane == 0) { sA_[512] = m_prev; sA_[513] = mxl; sA_[514] = __expf(m_prev - mxl); } \
            m_prev = bl + mxl; } while (0)
        ML_LOAD(0);
        if (w == 0) { ML_LOADG(0); ML_SCALARS(0); ML_LOADG(1); }
        f32x4 accC[2][3];
#pragma unroll
        for (int dd = 0; dd < 2; ++dd)
#pragma unroll
            for (int e3 = 0; e3 < 3; ++e3) accC[dd][e3] = (f32x4){0.f, 0.f, 0.f, 0.f};
        for (int c = 0; c < NCHUNK; ++c) {
            const int sb = c & 1;
            LAS float* sA = (LAS float*)(lds + L_SC + sb * (SC_FLOATS * 4)); LAS float* sMx = sA + 128; LAS float* sB = sA + 256; LAS float* sWk = sA + 384; LAS float* sMisc = sA + 512;
            WG_BARRIER();
            {
                const f32x4 wk0 = *(const LAS f32x4*)(sWk + pseg * 8), wk1 = *(const LAS f32x4*)(sWk + pseg * 8 + 4);
#pragma unroll
                for (int i = 0; i < 4; ++i) { const int row = prow + 32 * i;
                    *(LAS u32x4*)(lds + L_Q + row * RS + pseg * 16) = rq[i]; *(LAS u32x4*)(lds + L_K + row * RS + pseg * 16) = rk[i];
                    const u32x4 v = rkt[i]; u32x4 o;
                    o.x = cvt_pk_bf16(bf_lo(v.x) * wk0[0], bf_hi(v.x) * wk0[1]); o.y = cvt_pk_bf16(bf_lo(v.y) * wk0[2], bf_hi(v.y) * wk0[3]);
                    o.z = cvt_pk_bf16(bf_lo(v.z) * wk1[0], bf_hi(v.z) * wk1[1]); o.w = cvt_pk_bf16(bf_lo(v.w) * wk1[2], bf_hi(v.w) * wk1[3]);
                    *(LAS u32x4*)(lds + L_KT + row * RS + pseg * 16) = o; }
                *(LAS u32x4*)(lds + L_VT + prow * RS + pseg * 16) = rvt;
            }
            WG_BARRIER_LDS();
            if (c + 1 < NCHUNK) ML_LOAD(c + 1);
            if (w == 0 && c + 1 < NCHUNK) { ML_SCALARS(sb ^ 1); if (c + 2 < NCHUNK) ML_LOADG(c + 2); }
            bf16x8 qf[4];
#pragma unroll
            for (int kk = 0; kk < 4; ++kk) qf[kk] = *(const LAS bf16x8*)(lds + L_Q + (16 * w + fr) * RS + (32 * kk + 8 * fq) * 2);
            f32x4 acc2[3] = {{0.f, 0.f, 0.f, 0.f}, {0.f, 0.f, 0.f, 0.f}, {0.f, 0.f, 0.f, 0.f}};
            const int ctb = L_CT + sb * 13056;
#pragma unroll
            for (int kk = 0; kk < 4; ++kk)
#pragma unroll
                for (int e3 = 0; e3 < 3; ++e3) { const bf16x8 cf = *(const LAS bf16x8*)(lds + ctb + (16 * e3 + fr) * RS + (32 * kk + 8 * fq) * 2);
                    acc2[e3] = __builtin_amdgcn_mfma_f32_16x16x32_bf16(qf[kk], cf, acc2[e3], 0, 0, 0); }
            const float mp = sMisc[0];
            const f32x4 mx4 = *(const LAS f32x4*)(sMx + 16 * w + 4 * fq), b4 = *(const LAS f32x4*)(sB + 16 * w + 4 * fq);
            {
                f32x4 wi;
#pragma unroll
                for (int j = 0; j < 4; ++j) wi[j] = __expf(mp - mx4[j]);
#pragma unroll
                for (int e3 = 0; e3 < 3; ++e3) acc2[e3] *= wi;
            }
            const int tl = 16 * w + fr; const float mxt = sMx[tl];
#pragma unroll
            for (int kk = 0; kk < 4; ++kk) {
                if (2 * kk <= w) {
                    unsigned pw[4] = {0u, 0u, 0u, 0u};
#pragma unroll
                    for (int h = 0; h < 2; ++h) { const int i = 2 * kk + h;
                        if (i <= w) { f32x4 sacc = {0.f, 0.f, 0.f, 0.f};
#pragma unroll
                            for (int k2 = 0; k2 < 4; ++k2) { const bf16x8 kf = *(const LAS bf16x8*)(lds + L_K + (16 * i + fr) * RS + (32 * k2 + 8 * fq) * 2);
                                sacc = __builtin_amdgcn_mfma_f32_16x16x32_bf16(kf, qf[k2], sacc, 0, 0, 0); }
                            const f32x4 av = *(const LAS f32x4*)(sA + 16 * i + 4 * fq); float pv[4];
#pragma unroll
                            for (int j = 0; j < 4; ++j) { const int sidx = 16 * i + 4 * fq + j; pv[j] = (sidx <= tl) ? sacc[j] * __expf(av[j] - mxt) : 0.f; }
                            pw[2 * h] = cvt_pk_bf16(pv[0], pv[1]); pw[2 * h + 1] = cvt_pk_bf16(pv[2], pv[3]); } }
                    const bf16x8 pf = __builtin_bit_cast(bf16x8, (u32x4){pw[0], pw[1], pw[2], pw[3]});
#pragma unroll
                    for (int e3 = 0; e3 < 3; ++e3) { const LAS unsigned char* vp = lds + L_VT + (16 * e3 + fr) * RS + (32 * kk + 4 * fq) * 2;
                        const u32x2 v0 = *(const LAS u32x2*)vp, v1 = *(const LAS u32x2*)(vp + 32);
                        const bf16x8 vf = __builtin_bit_cast(bf16x8, (u32x4){v0.x, v0.y, v1.x, v1.y});
                        acc2[e3] = __builtin_amdgcn_mfma_f32_16x16x32_bf16(pf, vf, acc2[e3], 0, 0, 0); }
                }
            }
            {
                const int s0 = c * CH;
#pragma unroll
                for (int j = 0; j < 4; ++j) { const float den = __shfl(acc2[2][j], lane & 48); const float thr = __expf(-(b4[j] + mx4[j]));
                    const float inv = 1.0f / fmaxf(fabsf(den), thr); bf16_t* hp = gH + (size_t)(s0 + 16 * w + 4 * fq + j) * DM + fr;
                    const unsigned hw = cvt_pk_bf16(acc2[0][j] * inv, acc2[1][j] * inv); hp[0] = (bf16_t)(hw & 0xffffu); hp[16] = (bf16_t)(hw >> 16); }
            }
            if (w < 4) {
                const float decay = sMisc[2];
                const int ctn = L_CT + (sb ^ 1) * 13056;
                bf16x8 vf[4][3];
#pragma unroll
                for (int kk = 0; kk < 4; ++kk)
#pragma unroll
                    for (int e3 = 0; e3 < 3; ++e3) vf[kk][e3] = *(const LAS bf16x8*)(lds + L_VT + (16 * e3 + fr) * RS + (32 * kk + 8 * fq) * 2);
#pragma unroll
                for (int dd = 0; dd < 2; ++dd) { const int dt = w + 4 * dd;
#pragma unroll
                    for (int e3 = 0; e3 < 3; ++e3) accC[dd][e3] *= decay;
#pragma unroll
                    for (int kk = 0; kk < 4; ++kk) { const bf16x8 kf = *(const LAS bf16x8*)(lds + L_KT + (16 * dt + fr) * RS + (32 * kk + 8 * fq) * 2);
#pragma unroll
                        for (int e3 = 0; e3 < 3; ++e3) accC[dd][e3] = __builtin_amdgcn_mfma_f32_16x16x32_bf16(kf, vf[kk][e3], accC[dd][e3], 0, 0, 0); }
#pragma unroll
                    for (int e3 = 0; e3 < 3; ++e3) { u32x2 o; o.x = cvt_pk_bf16(accC[dd][e3][0], accC[dd][e3][1]); o.y = cvt_pk_bf16(accC[dd][e3][2], accC[dd][e3][3]);
                        *(LAS u32x2*)(lds + ctn + (16 * e3 + fr) * RS + (16 * dt + 4 * fq) * 2) = o; } }
            }
        }
#undef ML_LOAD
#undef ML_LOADG
#undef ML_SCALARS
    }
    WG_BARRIER();
}

__device__ __forceinline__ void conv_item(const bf16_t* XB, const float* cw, const float* cb, bf16_t* XC, int idx) {
    const int r = idx >> 8, ch = (idx & 255) * 8, t = r & (SEQ - 1);
    u32x4 xv[4];
#pragma unroll
    for (int wv = 0; wv < 4; ++wv) { const int tt = t - 3 + wv; xv[wv] = (tt >= 0) ? *(const u32x4*)(XB + (size_t)(r - 3 + wv) * DM + ch) : (u32x4){0u, 0u, 0u, 0u}; }
    float acc[8];
    { const f32x4 b0 = *(const f32x4*)(cb + ch), b1 = *(const f32x4*)(cb + ch + 4);
#pragma unroll
      for (int j = 0; j < 4; ++j) { acc[j] = b0[j]; acc[4 + j] = b1[j]; } }
#pragma unroll
    for (int wv = 0; wv < 4; ++wv) { const f32x4 w0 = *(const f32x4*)(cw + wv * DM + ch), w1 = *(const f32x4*)(cw + wv * DM + ch + 4); const u32x4 x = xv[wv];
        acc[0] += w0[0] * bf_lo(x.x); acc[1] += w0[1] * bf_hi(x.x); acc[2] += w0[2] * bf_lo(x.y); acc[3] += w0[3] * bf_hi(x.y);
        acc[4] += w1[0] * bf_lo(x.z); acc[5] += w1[1] * bf_hi(x.z); acc[6] += w1[2] * bf_lo(x.w); acc[7] += w1[3] * bf_hi(x.w); }
    u32x4 o; o.x = cvt_pk_bf16(acc[0], acc[1]); o.y = cvt_pk_bf16(acc[2], acc[3]); o.z = cvt_pk_bf16(acc[4], acc[5]); o.w = cvt_pk_bf16(acc[6], acc[7]);
    *(u32x4*)(XC + (size_t)r * DM + ch) = o;
}
__device__ __forceinline__ void conv_own_tiles(const bf16_t* XB, const float* cw, const float* cb, bf16_t* XC) {
    const int tid = opaque_tid(), cg = tid & 31, rb = tid >> 5;
    StaticOrder S; S.init(MTOK, 4096, gridDim.x, blockIdx.x);
    for (int i = 0; ; ++i) {
        Unit u; if (!S.next(i, u)) break;
        if (u.pn >= 8) continue;
        const int ch = u.pn * 256 + cg * 8; const size_t row0 = (size_t)u.pm * 256 + rb * 16;
        f32x4 w0[4], w1[4];
#pragma unroll
        for (int wv = 0; wv < 4; ++wv) { w0[wv] = *(const f32x4*)(cw + wv * DM + ch); w1[wv] = *(const f32x4*)(cw + wv * DM + ch + 4); }
        const f32x4 b0 = *(const f32x4*)(cb + ch), b1 = *(const f32x4*)(cb + ch + 4);
        u32x4 xr[19];
#pragma unroll
        for (int k = 0; k < 19; ++k) xr[k] = (rb == 0 && k < 3) ? (u32x4){0u, 0u, 0u, 0u} : *(const u32x4*)(XB + (row0 + k - 3) * DM + ch);
#pragma unroll
        for (int r = 0; r < 16; ++r) {
            if (rb == 0 && r < 3) continue;
            f32x4 a0 = b0, a1 = b1;
#pragma unroll
            for (int wv = 0; wv < 4; ++wv) { const u32x4 x = xr[r + wv];
                a0 += w0[wv] * (f32x4){bf_lo(x.x), bf_hi(x.x), bf_lo(x.y), bf_hi(x.y)}; a1 += w1[wv] * (f32x4){bf_lo(x.z), bf_hi(x.z), bf_lo(x.w), bf_hi(x.w)}; }
            u32x4 o; o.x = cvt_pk_bf16(a0[0], a0[1]); o.y = cvt_pk_bf16(a0[2], a0[3]); o.z = cvt_pk_bf16(a1[0], a1[1]); o.w = cvt_pk_bf16(a1[2], a1[3]);
            *(u32x4*)(XC + (row0 + r) * DM + ch) = o; }
    }
}
__device__ __forceinline__ void conv_halo_rows(const bf16_t* XB, const float* cw, const float* cb, bf16_t* XC) {
    const int tid = opaque_tid();
    StaticOrder S; S.init(MTOK, 4096, gridDim.x, blockIdx.x);
    for (int i0 = 0; ; i0 += 4) {
        Unit u; if (!S.next(i0, u)) break;
        const int ui = i0 + tid / 96, rem = tid % 96;
        if (tid < 384 && S.next(ui, u)) { const int r = u.pm * 256 + (rem >> 5); conv_item(XB, cw, cb, XC, r * 256 + (u.pn >> 1) * 32 + (rem & 31)); }
    }
    asm volatile("s_waitcnt vmcnt(0)" ::: "memory");
    __syncthreads();
}
__device__ __forceinline__ void conv_phase(const bf16_t* XB, const float* cw, const float* cb, bf16_t* XC) {
    const int G = gridDim.x, rows_per = (MTOK + G - 1) / G, r0 = blockIdx.x * rows_per, r1 = min(MTOK, r0 + rows_per);
    const int tid = opaque_tid();
#pragma unroll 4
    for (int idx = r0 * 256 + tid; idx < r1 * 256; idx += 512) conv_item(XB, cw, cb, XC, idx);
}
__device__ __forceinline__ void scan1_phase(const unsigned* AU, float* PA, float* PH) {
    const int nth = gridDim.x * 512;
    for (int idx = blockIdx.x * 512 + opaque_tid(); idx < NBATCH * SCH * 1024; idx += nth) {
        const int ch = (idx & 1023) * 2, cc = (idx >> 10) & (SCH - 1), bb = idx >> 15;
        const size_t base = (size_t)(bb * SEQ + cc * SCL) * DM + ch;
        float h0 = 0.f, h1 = 0.f, p0 = 1.f, p1 = 1.f;
#pragma unroll 16
        for (int t = 0; t < SCL; ++t) { const u32x2 w = *(const u32x2*)(AU + base + (size_t)t * DM);
            const float a0 = 1.0f - bf_lo(w.x), a1 = 1.0f - bf_lo(w.y);
            h0 = a0 * h0 + bf_hi(w.x); h1 = a1 * h1 + bf_hi(w.y); p0 *= a0; p1 *= a1; }
        const size_t o = (size_t)(bb * SCH + cc) * DM + ch;
        *(f32x2*)(PA + o) = (f32x2){p0, p1}; *(f32x2*)(PH + o) = (f32x2){h0, h1};
    }
}
__device__ __forceinline__ void scan1_own_tiles(const unsigned* AU, float* PA, float* PH) {
    const int tid = opaque_tid();
    StaticOrder S; S.init(MTOK, 4096, gridDim.x, blockIdx.x);
    for (int i0 = 0; ; i0 += 4) {
        Unit u; const int ui = i0 + (tid >> 7);
        if (!S.next(i0, u)) break;
        if (S.next(ui, u)) {
            const int half = (tid >> 6) & 1, pair = tid & 63, ch = u.pn * 128 + 2 * pair;
            const int bb = u.pm >> 4, cc = (u.pm & 15) * 2 + half;
            const size_t base = (size_t)(u.pm * 256 + half * SCL) * DM + ch;
            float h0 = 0.f, h1 = 0.f, p0 = 1.f, p1 = 1.f;
#pragma unroll 16
            for (int t = 0; t < SCL; ++t) { const u32x2 w = *(const u32x2*)(AU + base + (size_t)t * DM);
                const float a0 = 1.0f - bf_lo(w.x), a1 = 1.0f - bf_lo(w.y);
                h0 = a0 * h0 + bf_hi(w.x); h1 = a1 * h1 + bf_hi(w.y); p0 *= a0; p1 *= a1; }
            const size_t o = (size_t)(bb * SCH + cc) * DM + ch;
            *(f32x2*)(PA + o) = (f32x2){p0, p1}; *(f32x2*)(PH + o) = (f32x2){h0, h1};
        }
    }
}
__device__ __forceinline__ void scan2_phase(const unsigned* AU, const float* PA, const float* PH, const bf16_t* GB, bf16_t* AB) {
    const int nth = gridDim.x * 512;
    for (int idx = blockIdx.x * 512 + opaque_tid(); idx < NBATCH * SCH * 1024; idx += nth) {
        const int ch = (idx & 1023) * 2, cc = (idx >> 10) & (SCH - 1), bb = idx >> 15;
        float h0 = 0.f, h1 = 0.f;
        for (int q = 0; q < cc; ++q) { const size_t o = (size_t)(bb * SCH + q) * DM + ch; const f32x2 pa = *(const f32x2*)(PA + o), ph = *(const f32x2*)(PH + o);
            h0 = pa[0] * h0 + ph[0]; h1 = pa[1] * h1 + ph[1]; }
        const size_t base = (size_t)(bb * SEQ + cc * SCL) * DM + ch;
#pragma unroll 16
        for (int t = 0; t < SCL; ++t) { const u32x2 w = *(const u32x2*)(AU + base + (size_t)t * DM);
            const unsigned g = *(const unsigned*)(GB + base + (size_t)t * DM);
            h0 = (1.0f - bf_lo(w.x)) * h0 + bf_hi(w.x); h1 = (1.0f - bf_lo(w.y)) * h1 + bf_hi(w.y);
            *(unsigned*)(AB + base + (size_t)t * DM) = cvt_pk_bf16(h0 * bf_lo(g), h1 * bf_hi(g)); }
    }
}

__device__ __forceinline__ void mlp_block(const Params& p, LAS unsigned char* lds, const XcdBarrier& xb, const int layer) {
    unsigned char* ws = p.ws;
    bf16_t* XR = (bf16_t*)(ws + OFF_XR);
    const float* MODp = (const float*)(ws + OFF_MOD);
    const float* mod = MODp + (layer * 2 + 1) * 4 * 6144;
    { EpiSqRelu e{(bf16_t*)(ws + SM_U)};
      gemm_phase(lds, (const bf16_t*)(ws + SM_HB), DM, (const bf16_t*)(ws + OFF_W_1) + (size_t)layer * DFF * DM, DM, MTOK, DFF, DM, 0, e); }
    xcd_barrier(xb);
    const bf16_t* A = (const bf16_t*)(ws + SM_U); const bf16_t* B = (const bf16_t*)(ws + OFF_W_2) + (size_t)layer * DFF * DM;
    unsigned* X = (unsigned*)(ws + OFF_XCH + (size_t)(layer == 0 ? 1 : 3) * SZ_XCH1); unsigned* cnt = (unsigned*)(ws + OFF_CNT) + (layer == 0 ? 1 : 3) * 64 * 64;
    if (layer == 0) {
        EpiResidNorm<false, false> e{XR, XR, mod + 4096, MODp + 2 * 4 * 6144, (bf16_t*)(ws + S1_HB), nullptr, nullptr, X, cnt};
        gemm_phase(lds, A, DFF, B, DFF, MTOK, DM, DFF, 0, e, 0);
        gemm_phase(lds, A, DFF, B, DFF, MTOK, DM, DFF, 0, e, 1);
        xcd_barrier(xb);
    } else {
        EpiResidNorm<false, true> e{XR, nullptr, mod + 4096, nullptr, nullptr, p.final_g, p.out, X, cnt};
        gemm_phase(lds, A, DFF, B, DFF, MTOK, DM, DFF, 0, e, 0);
        gemm_phase(lds, A, DFF, B, DFF, MTOK, DM, DFF, 0, e, 1);
    }
}
__global__ void __launch_bounds__(512) mega_fwd(Params p) {
    extern __shared__ __attribute__((aligned(16))) unsigned char smem[];
    LAS unsigned char* lds = (LAS unsigned char*)smem;
    unsigned char* ws = p.ws;
    if (ws == nullptr) cg::this_grid().sync();
    volatile LAS unsigned* xst = (volatile LAS unsigned*)(lds + L_XB);
    if (threadIdx.x < 4) xst[threadIdx.x] = 0u;
    __syncthreads();
    const XcdBarrier xb = xcd_barrier_post((unsigned*)(ws + OFF_BAR), xst);
    float* MOD = (float*)(ws + OFF_MOD);
    bf16_t* XR = (bf16_t*)(ws + OFF_XR);

    phase0(p, lds);
    xcd_barrier(xb);
    norm_phase<false>(p.x, MOD + 0 * 4 * 6144, (bf16_t*)(ws + S0_HB), nullptr, nullptr, (const unsigned long long*)(ws + OFF_MOD64), MOD);
    xcd_barrier(xb);
    gates_phase((const bf16_t*)(ws + S0_HB), (const bf16_t*)(ws + OFF_WG16), p.a_b_gate, (float*)(ws + OFF_LI), (float*)(ws + OFF_LF));
    { EpiProj e{(bf16_t*)(ws + S0_Q), (bf16_t*)(ws + S0_K), (bf16_t*)(ws + S0_KT), (bf16_t*)(ws + S0_VT), (bf16_t*)(ws + S0_O), 0};
      gemm_phase(lds, (const bf16_t*)(ws + S0_HB), DM, (const bf16_t*)(ws + OFF_W_AIN), DM, MTOK, 2048, DM, 0, e); }
    { EpiVT e{(bf16_t*)(ws + S0_VT)};
      gemm_phase(lds, (const bf16_t*)(ws + S0_HB), DM, (const bf16_t*)(ws + OFF_W_AIN) + (size_t)2048 * DM, DM, MTOK, 2048, DM, 0, e); }
    { EpiProj e{(bf16_t*)(ws + S0_Q), (bf16_t*)(ws + S0_K), (bf16_t*)(ws + S0_KT), (bf16_t*)(ws + S0_VT), (bf16_t*)(ws + S0_O), 16};
      gemm_phase(lds, (const bf16_t*)(ws + S0_HB), DM, (const bf16_t*)(ws + OFF_W_AIN) + (size_t)4096 * DM, DM, MTOK, 2048, DM, 0, e); }
    xcd_barrier(xb);
    mlstm_phase(lds, (const bf16_t*)(ws + S0_Q), (const bf16_t*)(ws + S0_K), (const bf16_t*)(ws + S0_KT), (const bf16_t*)(ws + S0_VT), (const float*)(ws + OFF_LI), (const float*)(ws + OFF_LF), (bf16_t*)(ws + S0_HH));
    xcd_barrier(xb);
    headnorm_phase((const bf16_t*)(ws + S0_HH), (const bf16_t*)(ws + S0_O), p.a_norm_g, (bf16_t*)(ws + S0_AB));
    xcd_barrier(xb);
    { EpiResidNorm<true, false> e{p.x, XR, MOD + 0 * 4 * 6144 + 4096, MOD + 1 * 4 * 6144, (bf16_t*)(ws + SM_HB), nullptr, nullptr, (unsigned*)(ws + OFF_XCH), (unsigned*)(ws + OFF_CNT)};
      gemm_phase(lds, (const bf16_t*)(ws + S0_AB), DM, (const bf16_t*)(ws + OFF_W_AOUT), DM, MTOK, DM, DM, 0, e, 0);
      gemm_phase(lds, (const bf16_t*)(ws + S0_AB), DM, (const bf16_t*)(ws + OFF_W_AOUT), DM, MTOK, DM, DM, 0, e, 1); }
    xcd_barrier(xb);
    mlp_block(p, lds, xb, 0);
    { EpiRgIn e{(bf16_t*)(ws + S1_XB), (bf16_t*)(ws + S1_GB)};
      gemm_phase(lds, (const bf16_t*)(ws + S1_HB), DM, (const bf16_t*)(ws + OFF_W_BIN), DM, MTOK, 4096, DM, 0, e); }
    conv_own_tiles((const bf16_t*)(ws + S1_XB), p.b_conv_w, p.b_conv_b, (bf16_t*)(ws + S1_XC));
    xcd_barrier(xb);
    conv_halo_rows((const bf16_t*)(ws + S1_XB), p.b_conv_w, p.b_conv_b, (bf16_t*)(ws + S1_XC));
    { EpiGate e{(const bf16_t*)(ws + S1_XC), p.b_b_ra, p.b_b_ri, p.b_lam, (unsigned*)(ws + S1_A)};
      gemm_phase(lds, (const bf16_t*)(ws + S1_XC), DM, (const bf16_t*)(ws + OFF_W_GATE), 256, MTOK, 4096, 256, 1, e); }
    scan1_own_tiles((const unsigned*)(ws + S1_A), (float*)(ws + OFF_SCAN), (float*)(ws + OFF_SCAN) + NBATCH * SCH * DM);
    xcd_barrier(xb);
    scan2_phase((const unsigned*)(ws + S1_A), (const float*)(ws + OFF_SCAN), (const float*)(ws + OFF_SCAN) + NBATCH * SCH * DM, (const bf16_t*)(ws + S1_GB), (bf16_t*)(ws + S1_AB));
    xcd_barrier(xb);
    { EpiResidNorm<false, false> e{XR, XR, MOD + 2 * 4 * 6144 + 4096, MOD + 3 * 4 * 6144, (bf16_t*)(ws + SM_HB), nullptr, nullptr, (unsigned*)(ws + OFF_XCH + 2 * SZ_XCH1), (unsigned*)(ws + OFF_CNT) + 2 * 64 * 64};
      gemm_phase(lds, (const bf16_t*)(ws + S1_AB), DM, (const bf16_t*)(ws + OFF_W_BOUT), DM, MTOK, DM, DM, 0, e, 0);
      gemm_phase(lds, (const bf16_t*)(ws + S1_AB), DM, (const bf16_t*)(ws + OFF_W_BOUT), DM, MTOK, DM, DM, 0, e, 1); }
    xcd_barrier(xb);
    mlp_block(p, lds, xb, 1);

}

extern "C" void kernel_launch(void* const* d_in, const int* in_sizes, int n_in, void* d_out, int out_size, void* d_ws, size_t ws_size, hipStream_t stream) {
    static int grid_blocks = 0;
    if (grid_blocks == 0) {
        if (n_in != 20 || ws_size < WS_NEED) { fprintf(stderr, "kernel_launch: unexpected n_in %d or ws_size %zu (need %zu)\n", n_in, ws_size, (size_t)WS_NEED); grid_blocks = -1; return; }
        int dev = 0, cus = 0, per_cu = 0;
        (void)hipGetDevice(&dev);
        (void)hipDeviceGetAttribute(&cus, hipDeviceAttributeMultiprocessorCount, dev);
        if (hipFuncSetAttribute((const void*)mega_fwd, hipFuncAttributeMaxDynamicSharedMemorySize, LDS_BYTES) != hipSuccess) { fprintf(stderr, "kernel_launch: hipFuncSetAttribute failed\n"); }
        if (hipOccupancyMaxActiveBlocksPerMultiprocessor(&per_cu, (const void*)mega_fwd, 512, LDS_BYTES) != hipSuccess || per_cu < 1) { fprintf(stderr, "kernel_launch: occupancy query says %d\n", per_cu); per_cu = 1; }
        (void)hipGetLastError();
        grid_blocks = cus * per_cu;
    }
    if (grid_blocks < 0) return;
    (void)hipMemsetAsync((char*)d_ws + OFF_BAR, 0, 16384 + SZ_MOD64 + SZ_CNT, stream);
    Params p{};
    const float** pp = (const float**)&p;
    for (int i = 0; i < 20; ++i) pp[i] = (const float*)d_in[i];
    p.out = (float*)d_out; p.ws = (unsigned char*)d_ws;
    void* args[] = {&p};
    hipError_t e = hipLaunchCooperativeKernel((const void*)mega_fwd, dim3(grid_blocks), dim3(512), args, LDS_BYTES, stream);
    if (e != hipSuccess) fprintf(stderr, "cooperative launch failed: %s (grid %d)\n", hipGetErrorString(e), grid_blocks);
}
```

```cpp
#include <hip/hip_runtime.h>
#include <hip/hip_cooperative_groups.h>
#include <cstdio>
namespace cg = cooperative_groups;

#define LAS __attribute__((address_space(3)))
typedef unsigned short bf16_t;
typedef short bf16x8 __attribute__((ext_vector_type(8)));
typedef float f32x4 __attribute__((ext_vector_type(4)));
typedef float f32x2 __attribute__((ext_vector_type(2)));
typedef unsigned u32x4 __attribute__((ext_vector_type(4)));
typedef unsigned u32x2 __attribute__((ext_vector_type(2)));

constexpr int DM = 2048, NBATCH = 4, SEQ = 4096, MTOK = NBATCH * SEQ, DFF = 8192;
constexpr int NH = 8, DQK = 128, DV = 256, CH = 128, NCHUNK = SEQ / CH, INA = 6160;
constexpr int SCH = 32, SCL = SEQ / SCH;
constexpr float EPS = 1e-6f;

constexpr size_t OFF_MOD = 0;
constexpr size_t SZ_MOD = 4ull * 4 * 6144 * 4;
constexpr size_t OFF_BAR = OFF_MOD + SZ_MOD;
constexpr size_t SZ_BAR = 3456 * 4;
constexpr size_t OFF_MOD64 = OFF_BAR + 16384;
constexpr size_t SZ_MOD64 = 4ull * 4 * 6144 * 8;
constexpr size_t OFF_CNT = OFF_MOD64 + SZ_MOD64;
constexpr size_t SZ_CNT = 4ull * 64 * 256;
constexpr size_t OFF_WG16 = OFF_CNT + SZ_CNT;
constexpr size_t OFF_SCAN = OFF_WG16 + 16ull * 2048 * 2;
constexpr size_t OFF_LI = OFF_SCAN + 2ull * 4 * SCH * 2048 * 4;
constexpr size_t OFF_LF = OFF_LI + 4ull * 8 * 4096 * 4;
constexpr size_t OFF_XCH = OFF_LF + 4ull * 8 * 4096 * 4;
constexpr size_t SZ_XCH1 = 64ull * 256 * 8 * 4;
constexpr size_t OFF_SS = OFF_XCH + 4 * SZ_XCH1;
constexpr size_t OFF_W = 11ull << 20;
static_assert(OFF_SS + (size_t)16384 * 64 * 4 <= OFF_W, "ctl region");
constexpr size_t OFF_W_AIN = OFF_W;
constexpr size_t OFF_W_AOUT = OFF_W_AIN + 6144ull * 2048 * 2;
constexpr size_t OFF_W_BIN = OFF_W_AOUT + 2048ull * 2048 * 2;
constexpr size_t OFF_W_BOUT = OFF_W_BIN + 4096ull * 2048 * 2;
constexpr size_t OFF_W_GATE = OFF_W_BOUT + 2048ull * 2048 * 2;
constexpr size_t OFF_W_1 = OFF_W_GATE + 4096ull * 256 * 2;
constexpr size_t OFF_W_2 = OFF_W_1 + 2ull * 8192 * 2048 * 2;
constexpr size_t OFF_XR = OFF_W_2 + 2ull * 8192 * 2048 * 2;
constexpr size_t OFF_SCR = OFF_XR + (size_t)MTOK * DM * 4;
constexpr size_t SZ_ROWB = (size_t)MTOK * DM * 2;
constexpr size_t S0_HB = OFF_SCR, S0_Q = S0_HB + SZ_ROWB, S0_K = S0_Q + SZ_ROWB / 2, S0_KT = S0_K + SZ_ROWB / 2, S0_VT = S0_KT + SZ_ROWB / 2,
                 S0_O = S0_VT + SZ_ROWB, S0_HH = S0_O + SZ_ROWB, S0_END = S0_HH + 2 * SZ_ROWB, S0_AB = S0_HB;
constexpr size_t SM_U = OFF_SCR + SZ_ROWB, SM_HB = OFF_SCR + 5 * SZ_ROWB;
constexpr size_t S1_HB = OFF_SCR, S1_XB = S1_HB + SZ_ROWB, S1_GB = S1_XB + SZ_ROWB, S1_XC = S1_GB + SZ_ROWB, S1_A = S1_XC + SZ_ROWB  , S1_AB = S1_XC;
constexpr size_t WS_NEED = S0_END;

constexpr int L_XB = 148864;
constexpr int L_HS = L_XB + 64;
constexpr int HS_RS = 80;
constexpr int LDS_BYTES = L_HS + 128 * HS_RS;
constexpr int L_RT = 131072;

typedef __bf16 bf16x2_t __attribute__((ext_vector_type(2)));
__device__ __forceinline__ unsigned cvt_pk_bf16(float lo, float hi) { const bf16x2_t r = __builtin_convertvector((f32x2){lo, hi}, bf16x2_t); return __builtin_bit_cast(unsigned, r); }
__device__ __forceinline__ float bf_lo(unsigned w) { return __uint_as_float(w << 16); }
__device__ __forceinline__ float bf_hi(unsigned w) { return __uint_as_float(w & 0xffff0000u); }
__device__ __forceinline__ float wave_sum(float v) {
#pragma unroll
    for (int o = 1; o < 64; o <<= 1) v += __shfl_xor(v, o);
    return v;
}
__device__ __forceinline__ float sigmoidf_(float x) { return 1.0f / (1.0f + __expf(-x)); }
__device__ __forceinline__ int opaque_tid() { int t = threadIdx.x; asm volatile("" : "+v"(t)); return t; }
#define LDS_FENCE() asm volatile("s_waitcnt lgkmcnt(0)" ::: "memory")
#define WG_BARRIER() do { asm volatile("s_waitcnt vmcnt(0) lgkmcnt(0)" ::: "memory"); __builtin_amdgcn_s_barrier(); asm volatile("" ::: "memory"); } while (0)
#define WG_BARRIER_LDS() do { asm volatile("s_waitcnt lgkmcnt(0)" ::: "memory"); __builtin_amdgcn_s_barrier(); asm volatile("" ::: "memory"); } while (0)


#define XB_TMO      128
#define XB_XCNT(j)  (256  + 64 * (j))
#define XB_XSUB(j)  (1280 + 64 * (j))
#define XB_XGEN(j)  (2304 + 64 * (j))
#define XB_TOP      3328
#define XB_TOPGEN   3392
#define XB_SPIN_CAP (1u << 20)
__device__ __forceinline__ unsigned xb_ld(unsigned* p)              { return __hip_atomic_load(p, __ATOMIC_RELAXED, __HIP_MEMORY_SCOPE_AGENT); }
__device__ __forceinline__ unsigned xb_add(unsigned* p, unsigned v) { return __hip_atomic_fetch_add(p, v, __ATOMIC_RELAXED, __HIP_MEMORY_SCOPE_AGENT); }
__device__ __forceinline__ unsigned xb_xcc_id() { return (unsigned)__builtin_amdgcn_s_getreg((3 << 11) | 20) & 0xFu; }
#define XB_SPIN(cond, bar) do { unsigned _sp = 0; while (cond) { __builtin_amdgcn_s_sleep(1); \
    if ((++_sp & 255u) == 0u) { if (xb_ld(&(bar)[XB_TMO])) break; if (_sp > XB_SPIN_CAP) { atomicAdd(&(bar)[XB_TMO], 1u); break; } } } } while (0)
struct XcdBarrier { unsigned* bar; unsigned x; volatile LAS unsigned* st; };
__device__ __forceinline__ XcdBarrier xcd_barrier_post(unsigned* bar, volatile LAS unsigned* st) {
    XcdBarrier b; b.bar = bar; b.x = xb_xcc_id(); b.st = st;
    if (threadIdx.x == 0) (void)xb_add(&bar[XB_XCNT(b.x)], 1u);
    return b;
}
__device__ __forceinline__ void xcd_barrier_complete(unsigned* bar, unsigned x, unsigned& nloc, unsigned& nx) {
    const unsigned G = gridDim.x * gridDim.y * gridDim.z;
    unsigned sum, cnt, mine, sp = 0u;
    for (;;) {
        sum = 0u; cnt = 0u; mine = 0u;
#pragma unroll
        for (unsigned j = 0; j < 16; ++j) { const unsigned c = xb_ld(&bar[XB_XCNT(j)]); sum += c; cnt += (c > 0u) ? 1u : 0u; mine = (j == x) ? c : mine; }
        if (sum == G) break;
        __builtin_amdgcn_s_sleep(1);
        if ((++sp & 255u) == 0u) { if (xb_ld(&bar[XB_TMO])) break; if (sp > XB_SPIN_CAP) { atomicAdd(&bar[XB_TMO], 1u); break; } }
    }
    nloc = mine > 0u ? mine : 1u; nx = cnt > 0u ? cnt : 1u;
}
__device__ __forceinline__ void xcd_barrier(const XcdBarrier& b) {
    asm volatile("s_waitcnt vmcnt(0)" ::: "memory");
    __syncthreads();
    if (threadIdx.x == 0) {
        unsigned* bar = b.bar;
        __builtin_amdgcn_s_waitcnt(0);
        unsigned nloc = b.st[0], nx = b.st[1];
        if (nloc == 0u) { xcd_barrier_complete(bar, b.x, nloc, nx); b.st[0] = nloc; b.st[1] = nx; }
        const unsigned old = xb_add(&bar[XB_XSUB(b.x)], 1u);
        const unsigned gen = old / nloc;
        if (old + 1u == (gen + 1u) * nloc) {
            __builtin_amdgcn_fence(__ATOMIC_RELEASE, "agent");
            asm volatile("s_waitcnt vmcnt(0)" ::: "memory");
            const unsigned og = xb_add(&bar[XB_TOP], 1u);
            const unsigned tg = og / nx;
            if (og + 1u == (tg + 1u) * nx) xb_add(&bar[XB_TOPGEN], 1u);
            else XB_SPIN(xb_ld(&bar[XB_TOPGEN]) == tg, bar);
            __builtin_amdgcn_fence(__ATOMIC_ACQUIRE, "agent");
            xb_add(&bar[XB_XGEN(b.x)], 1u);
            asm volatile("s_waitcnt vmcnt(0)" ::: "memory");
        } else {
            XB_SPIN(xb_ld(&bar[XB_XGEN(b.x)]) == gen, bar);
            __builtin_amdgcn_fence(__ATOMIC_ACQUIRE, "agent");
            asm volatile("s_waitcnt vmcnt(0)" ::: "memory");
        }
    }
    __syncthreads();
}

struct Params {
    const float *x, *c, *ada_w, *ada_b, *a_w_in, *a_b_gate, *a_norm_g, *a_w_out, *b_w_in, *b_conv_w, *b_conv_b, *b_w_ra, *b_b_ra, *b_w_ri, *b_b_ri, *b_lam,
        *b_w_out, *mlp_w1, *mlp_w2, *final_g;
    float* out;
    unsigned char* ws;
};

constexpr int BM = 256, BK = 64, HALF = 128, HTB = HALF * BK * 2, NXCD = 8, WGM = 8;
__device__ __forceinline__ int lds_byte(int r, int c) { const int st = (r >> 4) * 2 + (c >> 5), rr = r & 15, cc = c & 31, ob = rr * 64 + cc * 2; return st * 1024 + (ob ^ (((ob >> 9) & 1) << 5)); }
__device__ __forceinline__ void stage_rc(int b, int& R, int& C) { const int st = b / 1024, sb = b % 1024, swz = sb ^ (((sb >> 9) & 1) << 5); R = (st >> 1) * 16 + swz / 64; C = (st & 1) * 32 + (swz % 64) / 2; }
__device__ __forceinline__ int perm32(int rho) { const int n = rho >> 4, i = rho & 15; return 8 * (i >> 2) + 4 * n + (i & 3); }
struct Unit { int pm, pn; };
struct StaticOrder {
    int nM, nN, nwg, G, c;
    __device__ void init(int M, int N, int G_, int c_) { nM = M / BM; nN = N / BM; nwg = nM * nN; G = G_; c = c_; }
    __device__ bool next(int i, Unit& u) const {
        const long L = (long)i * G + c; if (L >= nwg) return false;
        int wgid = (int)L; { const int q = nwg / NXCD, r = nwg % NXCD, xcd = wgid % NXCD, off = wgid / NXCD; wgid = (xcd < r ? xcd * (q + 1) : r * (q + 1) + (xcd - r) * q) + off; }
        const int nig = WGM * nN, gid = wgid / nig, fm = gid * WGM, gsz = (nM - fm) < WGM ? (nM - fm) : WGM;
        u.pm = fm + ((wgid % nig) % gsz); u.pn = (wgid % nig) / gsz; return true;
    }
};

template <class Epi>
__device__ __forceinline__ void gemm_phase(LAS unsigned char* lds, const bf16_t* A, int lda, const bf16_t* Bt, int ldb, int M, int N, int K, int asel, const Epi& E, const int fixed_round = -1) {
    const int tid = opaque_tid(), wid = __builtin_amdgcn_readfirstlane(tid >> 6), lane = tid & 63, wr = wid >> 2, wc = wid & 3, fr = lane & 15, fq = lane >> 4;
    const int nt = K / BK;
    constexpr bool NOSWAP = Epi::NOSWAP;
    StaticOrder S; S.init(M, N, gridDim.x, blockIdx.x);
    unsigned voffA[2], voffB[2];
#pragma unroll
    for (int i = 0; i < 2; ++i) { int R, C; stage_rc(tid * 16 + i * 8192, R, C); const int Rb = Epi::PERM ? ((R & ~31) + perm32(R & 31)) : R;
        voffA[i] = (unsigned)(R * lda + C) * 2u; voffB[i] = (unsigned)(Rb * ldb + C) * 2u; }
    const size_t kstep = (size_t)(BK * 2);
    const size_t hstepA = (size_t)HALF * lda * 2, hstepB = (size_t)HALF * ldb * 2;
    const size_t tstepA = 2 * hstepA, tstepB = 2 * hstepB;
    const unsigned ldsw = (unsigned)wid * 1024u;
    const int aoff = lds_byte(wr * 64 + fr, fq * 8), boff = lds_byte(wc * 32 + fr, fq * 8);
#define PG8_SA(b, h) (((b) * 2 + (h)) * HTB)
#define PG8_SB(b, h) ((4 + (b) * 2 + (h)) * HTB)
#define PG8_STAGE(bufoff, gbase, voff) do { _Pragma("unroll") for (int _i = 0; _i < 2; ++_i) \
        __builtin_amdgcn_global_load_lds((const unsigned*)((const char*)(gbase) + (voff)[_i]), (LAS unsigned*)(lds + (bufoff) + ldsw + _i * 8192), 16, 0, 0); } while (0)
#define PG8_LDA(dst, b, h) do { _Pragma("unroll") for (int m = 0; m < 4; ++m) _Pragma("unroll") for (int k = 0; k < 2; ++k) dst[m][k] = *(const LAS bf16x8*)(lds + PG8_SA(b, h) + aoff + m * 2048 + k * 1024); } while (0)
#define PG8_LDB(dst, b, h) do { _Pragma("unroll") for (int n = 0; n < 2; ++n) _Pragma("unroll") for (int k = 0; k < 2; ++k) dst[n][k] = *(const LAS bf16x8*)(lds + PG8_SB(b, h) + boff + n * 2048 + k * 1024); } while (0)
#define PG8_MMA(ai, bj, At, Bt_) do { __builtin_amdgcn_s_setprio(1); _Pragma("unroll") for (int m = 0; m < 4; ++m) _Pragma("unroll") for (int n = 0; n < 2; ++n) _Pragma("unroll") for (int k = 0; k < 2; ++k) \
        acc[ai][bj][m][n] = NOSWAP ? __builtin_amdgcn_mfma_f32_16x16x32_bf16(At[m][k], Bt_[n][k], acc[ai][bj][m][n], 0, 0, 0) : __builtin_amdgcn_mfma_f32_16x16x32_bf16(Bt_[n][k], At[m][k], acc[ai][bj][m][n], 0, 0, 0); __builtin_amdgcn_s_setprio(0); } while (0)
#define PG8_WAIT_V(n) asm volatile("s_waitcnt vmcnt(" #n ")" ::: "memory")
#define PG8_WAIT_L(n) asm volatile("s_waitcnt lgkmcnt(" #n ")" ::: "memory")
#define PG8_BAR __builtin_amdgcn_s_barrier()
#define PG8_SCHED __builtin_amdgcn_sched_barrier(0)
#define PG8_ABASE(u_) ((const char*)A + (size_t)(u_).pm * tstepA + (asel ? (size_t)((u_).pn >> 1) * 512 : (size_t)0))
    Unit cur, nxt; int ui = 0;
    if (fixed_round < 0) { if (!S.next(0, cur)) return; }
    else { const int c = blockIdx.x; cur.pm = 32 * fixed_round + 4 * (c & 7) + (c >> 6); cur.pn = (c >> 3) & 7; }
    f32x4 acc[2][2][4][2];
#pragma unroll
    for (int a = 0; a < 2; ++a)
#pragma unroll
        for (int b = 0; b < 2; ++b)
#pragma unroll
            for (int m = 0; m < 4; ++m)
#pragma unroll
                for (int n = 0; n < 2; ++n) acc[a][b][m][n] = (f32x4){0.f, 0.f, 0.f, 0.f};
    bf16x8 At[4][2], B0[2][2], B1[2][2];
    const char* cA = PG8_ABASE(cur); const char* cB = (const char*)Bt + (size_t)cur.pn * tstepB;
    PG8_STAGE(PG8_SB(0, 0), cB, voffB); PG8_STAGE(PG8_SA(0, 0), cA, voffA); PG8_STAGE(PG8_SB(0, 1), cB + hstepB, voffB); PG8_STAGE(PG8_SA(0, 1), cA + hstepA, voffA);
    if (wr == 1) PG8_BAR;
    PG8_WAIT_V(4); PG8_BAR;
    PG8_STAGE(PG8_SB(1, 0), cB + kstep, voffB); PG8_STAGE(PG8_SA(1, 0), cA + kstep, voffA); PG8_STAGE(PG8_SB(1, 1), cB + hstepB + kstep, voffB);
    PG8_WAIT_V(6); PG8_BAR;
    for (;;) {
        const bool has_next = (fixed_round < 0) && S.next(ui + 1, nxt);
        const char* nA = has_next ? PG8_ABASE(nxt) : cA; const char* nB = has_next ? (const char*)Bt + (size_t)nxt.pn * tstepB : cB;
        for (int t = 0; t < nt; t += 2) {
            const bool last = (t == nt - 2);
            const char* a1 = cA + (size_t)(t + 1) * kstep;
            const char* a2 = last ? nA : cA + (size_t)(t + 2) * kstep; const char* b2 = last ? nB : cB + (size_t)(t + 2) * kstep;
            const char* a3 = a2 + kstep; const char* b3 = b2 + kstep;
            PG8_LDB(B0, 0, 0); PG8_SCHED; PG8_LDA(At, 0, 0); PG8_STAGE(PG8_SA(1, 1), a1 + hstepA, voffA);
            PG8_WAIT_L(8); PG8_BAR; PG8_WAIT_L(0); PG8_MMA(0, 0, At, B0); PG8_BAR; PG8_SCHED;
            PG8_LDB(B1, 0, 1); PG8_STAGE(PG8_SB(0, 0), b2, voffB);
            PG8_BAR; PG8_WAIT_L(0); PG8_MMA(0, 1, At, B1); PG8_BAR;
            PG8_LDA(At, 0, 1); PG8_STAGE(PG8_SA(0, 0), a2, voffA);
            PG8_BAR; PG8_WAIT_L(0); PG8_MMA(1, 0, At, B0); PG8_BAR; PG8_SCHED;
            PG8_STAGE(PG8_SB(0, 1), b2 + hstepB, voffB);
            PG8_WAIT_V(6); PG8_BAR; PG8_MMA(1, 1, At, B1); PG8_BAR;
            PG8_LDB(B0, 1, 0); PG8_SCHED; PG8_LDA(At, 1, 0); PG8_STAGE(PG8_SA(0, 1), a2 + hstepA, voffA);
            PG8_WAIT_L(8); PG8_BAR; PG8_WAIT_L(0); PG8_MMA(0, 0, At, B0); PG8_BAR; PG8_SCHED;
            PG8_LDB(B1, 1, 1); PG8_STAGE(PG8_SB(1, 0), b3, voffB);
            PG8_BAR; PG8_WAIT_L(0); PG8_MMA(0, 1, At, B1); PG8_BAR;
            PG8_LDA(At, 1, 1); PG8_STAGE(PG8_SA(1, 0), a3, voffA);
            PG8_BAR; PG8_WAIT_L(0); PG8_MMA(1, 0, At, B0); PG8_BAR; PG8_SCHED;
            PG8_STAGE(PG8_SB(1, 1), b3 + hstepB, voffB);
            PG8_WAIT_V(6); PG8_BAR; PG8_MMA(1, 1, At, B1); PG8_BAR;
            if constexpr (Epi::HEADSCALE) {
                if (t & 2) {
                    const LAS float* rt = (const LAS float*)(lds + L_RT) + (t >> 2);
#pragma unroll
                    for (int ai = 0; ai < 2; ++ai)
#pragma unroll
                        for (int m = 0; m < 4; ++m) { const float f = rt[(ai * HALF + wr * 64 + m * 16 + fr) * 8];
#pragma unroll
                            for (int bj = 0; bj < 2; ++bj)
#pragma unroll
                                for (int n = 0; n < 2; ++n) acc[ai][bj][m][n] *= f; }
                }
            }
        }
        if constexpr (!Epi::AFTER_DRAIN) E(acc, cur, wr, wc, fr, fq);
        if (!has_next) break;
#pragma unroll
        for (int a = 0; a < 2; ++a)
#pragma unroll
            for (int b = 0; b < 2; ++b)
#pragma unroll
                for (int m = 0; m < 4; ++m)
#pragma unroll
                    for (int n = 0; n < 2; ++n) acc[a][b][m][n] = (f32x4){0.f, 0.f, 0.f, 0.f};
        cur = nxt; cA = nA; cB = nB; ++ui;
    }
    PG8_WAIT_V(0);
    if (wr == 0) PG8_BAR;
    PG8_BAR;
    if constexpr (Epi::AFTER_DRAIN) E.fused(acc, cur, wr, wc, fr, fq, lds);
#undef PG8_SA
#undef PG8_SB
#undef PG8_STAGE
#undef PG8_LDA
#undef PG8_LDB
#undef PG8_MMA
#undef PG8_WAIT_V
#undef PG8_WAIT_L
#undef PG8_BAR
#undef PG8_SCHED
#undef PG8_ABASE
}

typedef f32x4 AccT[2][2][4][2];

template <bool IN_F32>
struct EpiResid {
    static constexpr bool PERM = true, NOSWAP = false, AFTER_DRAIN = false, HEADSCALE = false;
    const void* Xin; bf16_t* Xout; const float* gate;
    __device__ __forceinline__ void operator()(const AccT& acc, const Unit& u, int wr, int wc, int fr, int fq) const {
        const int row0 = u.pm * BM + wr * 64 + fr, col0 = u.pn * BM + wc * 32 + 8 * fq;
        const float* g = gate + (u.pm >> 4) * 6144 + col0;
        f32x4 gv[2][2];
#pragma unroll
        for (int bj = 0; bj < 2; ++bj)
#pragma unroll
            for (int n = 0; n < 2; ++n) gv[bj][n] = *(const f32x4*)(g + bj * HALF + n * 4);
#pragma unroll
        for (int ai = 0; ai < 2; ++ai) {
            f32x4 xin[4][2][2];
#pragma unroll
            for (int m = 0; m < 4; ++m) { const size_t off = (size_t)(row0 + ai * HALF + m * 16) * DM + col0;
#pragma unroll
                for (int bj = 0; bj < 2; ++bj) {
                    if (IN_F32) { xin[m][bj][0] = *(const f32x4*)((const float*)Xin + off + bj * HALF); xin[m][bj][1] = *(const f32x4*)((const float*)Xin + off + bj * HALF + 4); }
                    else { const u32x4 w = *(const u32x4*)((const bf16_t*)Xin + off + bj * HALF);
                        xin[m][bj][0] = (f32x4){bf_lo(w.x), bf_hi(w.x), bf_lo(w.y), bf_hi(w.y)}; xin[m][bj][1] = (f32x4){bf_lo(w.z), bf_hi(w.z), bf_lo(w.w), bf_hi(w.w)}; } } }
            asm volatile("" ::: "memory");
#pragma unroll
            for (int m = 0; m < 4; ++m) { const size_t off = (size_t)(row0 + ai * HALF + m * 16) * DM + col0;
#pragma unroll
                for (int bj = 0; bj < 2; ++bj) { const f32x4 v0 = xin[m][bj][0] + gv[bj][0] * acc[ai][bj][m][0], v1 = xin[m][bj][1] + gv[bj][1] * acc[ai][bj][m][1];
                    u32x4 w; w.x = cvt_pk_bf16(v0[0], v0[1]); w.y = cvt_pk_bf16(v0[2], v0[3]); w.z = cvt_pk_bf16(v1[0], v1[1]); w.w = cvt_pk_bf16(v1[2], v1[3]);
                    *(u32x4*)(Xout + off + bj * HALF) = w; } }
            asm volatile("" ::: "memory");
        }
    }
};
template <bool IN_F32, bool FINAL>
struct EpiResidNorm {
    static constexpr bool PERM = true, NOSWAP = false, AFTER_DRAIN = true, HEADSCALE = IN_F32;
    const void* Xin; bf16_t* Xout; const float* gate; const float* modn; bf16_t* H; const float* fg; float* OUT; unsigned* X; unsigned* cnt;
    __device__ __forceinline__ void fused(AccT& acc, const Unit& u, int wr, int wc, int fr, int fq, LAS unsigned char* lds) const {
        const int tid = opaque_tid(), wid = tid >> 6, lane = tid & 63;
        const int row0 = u.pm * BM + wr * 64 + fr, col0 = u.pn * BM + wc * 32 + 8 * fq, bb = u.pm >> 4;
        LAS float* P = (LAS float*)lds; LAS float* Ssh = (LAS float*)(lds + 8192);
        {
            const float* g = gate + bb * 6144 + col0;
            f32x4 gv[2][2];
#pragma unroll
            for (int bj = 0; bj < 2; ++bj)
#pragma unroll
                for (int n = 0; n < 2; ++n) gv[bj][n] = *(const f32x4*)(g + bj * HALF + n * 4);
#pragma unroll
            for (int ai = 0; ai < 2; ++ai) {
                f32x4 xin[4][2][2];
#pragma unroll
                for (int m = 0; m < 4; ++m) { const size_t off = (size_t)(row0 + ai * HALF + m * 16) * DM + col0;
#pragma unroll
                    for (int bj = 0; bj < 2; ++bj) {
                        if (IN_F32) { xin[m][bj][0] = *(const f32x4*)((const float*)Xin + off + bj * HALF); xin[m][bj][1] = *(const f32x4*)((const float*)Xin + off + bj * HALF + 4); }
                        else { const u32x4 w = *(const u32x4*)((const bf16_t*)Xin + off + bj * HALF);
                            xin[m][bj][0] = (f32x4){bf_lo(w.x), bf_hi(w.x), bf_lo(w.y), bf_hi(w.y)}; xin[m][bj][1] = (f32x4){bf_lo(w.z), bf_hi(w.z), bf_lo(w.w), bf_hi(w.w)}; } } }
                asm volatile("" ::: "memory");
#pragma unroll
                for (int m = 0; m < 4; ++m) { const size_t off = (size_t)(row0 + ai * HALF + m * 16) * DM + col0;
#pragma unroll
                    for (int bj = 0; bj < 2; ++bj) { const f32x4 v0 = xin[m][bj][0] + gv[bj][0] * acc[ai][bj][m][0], v1 = xin[m][bj][1] + gv[bj][1] * acc[ai][bj][m][1];
                        u32x4 w; w.x = cvt_pk_bf16(v0[0], v0[1]); w.y = cvt_pk_bf16(v0[2], v0[3]); w.z = cvt_pk_bf16(v1[0], v1[1]); w.w = cvt_pk_bf16(v1[2], v1[3]);
                        if (!FINAL) *(u32x4*)(Xout + off + bj * HALF) = w;
                        acc[ai][bj][m][0] = (f32x4){bf_lo(w.x), bf_hi(w.x), bf_lo(w.y), bf_hi(w.y)}; acc[ai][bj][m][1] = (f32x4){bf_lo(w.z), bf_hi(w.z), bf_lo(w.w), bf_hi(w.w)}; } }
                asm volatile("" ::: "memory");
            }
        }
#pragma unroll
        for (int ai = 0; ai < 2; ++ai)
#pragma unroll
            for (int m = 0; m < 4; ++m) { float sq = 0.f;
#pragma unroll
                for (int bj = 0; bj < 2; ++bj)
#pragma unroll
                    for (int n = 0; n < 2; ++n) { const f32x4 x = acc[ai][bj][m][n]; sq += (x[0] * x[0] + x[1] * x[1]) + (x[2] * x[2] + x[3] * x[3]); }
                sq += __shfl_xor(sq, 16); sq += __shfl_xor(sq, 32);
                if (fq == 0) P[(ai * HALF + wr * 64 + m * 16 + fr) * 4 + wc] = sq; }
        WG_BARRIER_LDS();
        if (tid < 256) { const float t = (P[tid * 4] + P[tid * 4 + 1]) + (P[tid * 4 + 2] + P[tid * 4 + 3]);
            __hip_atomic_store(X + ((size_t)u.pm * 256 + tid) * 8 + u.pn, __float_as_uint(t), __ATOMIC_RELAXED, __HIP_MEMORY_SCOPE_AGENT); }
        asm volatile("s_waitcnt vmcnt(0)" ::: "memory");
        if (tid < 256 && lane == 0) __hip_atomic_fetch_add(cnt + 64 * u.pm, 1u, __ATOMIC_RELAXED, __HIP_MEMORY_SCOPE_AGENT);
        if (wid == 0) { unsigned spins = 0;
            while ((unsigned)__builtin_amdgcn_readfirstlane((int)__hip_atomic_load(cnt + 64 * u.pm, __ATOMIC_RELAXED, __HIP_MEMORY_SCOPE_AGENT)) < 32u) { __builtin_amdgcn_s_sleep(1); if (++spins > (1u << 22)) break; }
            __builtin_amdgcn_fence(__ATOMIC_ACQUIRE, "agent");
            asm volatile("s_waitcnt vmcnt(0)" ::: "memory"); }
        WG_BARRIER();
        if (tid < 256) { const unsigned* xp = X + ((size_t)u.pm * 256 + tid) * 8; float t = 0.f;
#pragma unroll
            for (int q = 0; q < 8; ++q) t += __uint_as_float(__hip_atomic_load(xp + q, __ATOMIC_RELAXED, __HIP_MEMORY_SCOPE_AGENT));
            Ssh[tid] = rsqrtf(t * (1.0f / DM) + EPS); }
        WG_BARRIER();
        f32x4 c0[2][2], c1[2][2];
#pragma unroll
        for (int bj = 0; bj < 2; ++bj)
#pragma unroll
            for (int n = 0; n < 2; ++n) { const int col = col0 + bj * HALF + n * 4;
                if (FINAL) { c0[bj][n] = *(const f32x4*)(fg + col); c1[bj][n] = (f32x4){0.f, 0.f, 0.f, 0.f}; }
                else { c0[bj][n] = *(const f32x4*)(modn + bb * 6144 + DM + col) + 1.0f; c1[bj][n] = *(const f32x4*)(modn + bb * 6144 + col); } }
#pragma unroll
        for (int ai = 0; ai < 2; ++ai)
#pragma unroll
            for (int m = 0; m < 4; ++m) { const int rl = ai * HALF + wr * 64 + m * 16 + fr; const float rstd = Ssh[rl]; const size_t off = (size_t)(row0 + ai * HALF + m * 16) * DM + col0;
#pragma unroll
                for (int bj = 0; bj < 2; ++bj) { const f32x4 o0 = acc[ai][bj][m][0] * rstd * c0[bj][0] + c1[bj][0], o1 = acc[ai][bj][m][1] * rstd * c0[bj][1] + c1[bj][1];
                    if (FINAL) { *(f32x4*)(OUT + off + bj * HALF) = o0; *(f32x4*)(OUT + off + bj * HALF + 4) = o1; }
                    else { u32x4 w; w.x = cvt_pk_bf16(o0[0], o0[1]); w.y = cvt_pk_bf16(o0[2], o0[3]); w.z = cvt_pk_bf16(o1[0], o1[1]); w.w = cvt_pk_bf16(o1[2], o1[3]);
                        *(u32x4*)(H + off + bj * HALF) = w; } } }
        WG_BARRIER_LDS();
    }
};
struct EpiSqRelu {
    static constexpr bool PERM = true, NOSWAP = false, AFTER_DRAIN = false, HEADSCALE = false;
    bf16_t* O;
    __device__ __forceinline__ void operator()(const AccT& acc, const Unit& u, int wr, int wc, int fr, int fq) const {
        const int row0 = u.pm * BM + wr * 64 + fr, col0 = u.pn * BM + wc * 32 + 8 * fq;
#pragma unroll
        for (int ai = 0; ai < 2; ++ai)
#pragma unroll
            for (int m = 0; m < 4; ++m) { bf16_t* rowp = O + (size_t)(row0 + ai * HALF + m * 16) * DFF + col0;
#pragma unroll
                for (int bj = 0; bj < 2; ++bj) { f32x4 v0 = acc[ai][bj][m][0], v1 = acc[ai][bj][m][1];
#pragma unroll
                    for (int j = 0; j < 4; ++j) { float a = fmaxf(v0[j], 0.f), b = fmaxf(v1[j], 0.f); v0[j] = a * a; v1[j] = b * b; }
                    u32x4 w; w.x = cvt_pk_bf16(v0[0], v0[1]); w.y = cvt_pk_bf16(v0[2], v0[3]); w.z = cvt_pk_bf16(v1[0], v1[1]); w.w = cvt_pk_bf16(v1[2], v1[3]);
                    *(u32x4*)(rowp + bj * HALF) = w; } }
    }
};
struct EpiProj {
    static constexpr bool PERM = true, NOSWAP = false, AFTER_DRAIN = false, HEADSCALE = false;
    bf16_t *Q, *Kn, *KT, *VT, *O; int pn_off;
    __device__ __forceinline__ void operator()(const AccT& acc, const Unit& u, int wr, int wc, int fr, int fq) const {
        const int row0 = u.pm * BM + wr * 64 + fr;
        const int pn = u.pn + pn_off;
        const int cl = wc * 32 + 8 * fq;
        if (pn < 8) {
            bf16_t* base = pn < 4 ? Q : Kn; const int colt = (pn & 3) * BM; const float sc = pn < 4 ? 0.08838834764831845f : 1.0f;
#pragma unroll
            for (int ai = 0; ai < 2; ++ai)
#pragma unroll
                for (int m = 0; m < 4; ++m) { bf16_t* rowp = base + (size_t)(row0 + ai * HALF + m * 16) * 1024 + colt + cl;
#pragma unroll
                    for (int bj = 0; bj < 2; ++bj) { const f32x4 v0 = acc[ai][bj][m][0] * sc, v1 = acc[ai][bj][m][1] * sc;
                        u32x4 w; w.x = cvt_pk_bf16(v0[0], v0[1]); w.y = cvt_pk_bf16(v0[2], v0[3]); w.z = cvt_pk_bf16(v1[0], v1[1]); w.w = cvt_pk_bf16(v1[2], v1[3]);
                        *(u32x4*)(rowp + bj * HALF) = w; } }
        }
        if (pn >= 16) {
            const int colt = (pn - 16) * BM;
#pragma unroll
            for (int ai = 0; ai < 2; ++ai)
#pragma unroll
                for (int m = 0; m < 4; ++m) { bf16_t* rowp = O + (size_t)(row0 + ai * HALF + m * 16) * DM + colt + cl;
#pragma unroll
                    for (int bj = 0; bj < 2; ++bj) { const f32x4 v0 = acc[ai][bj][m][0], v1 = acc[ai][bj][m][1];
                        u32x4 w; w.x = cvt_pk_bf16(v0[0], v0[1]); w.y = cvt_pk_bf16(v0[2], v0[3]); w.z = cvt_pk_bf16(v1[0], v1[1]); w.w = cvt_pk_bf16(v1[2], v1[3]);
                        *(u32x4*)(rowp + bj * HALF) = w; } }
        }
        if (pn >= 4 && pn < 16) {
            const bool isk = pn < 8;
            bf16_t* base = isk ? KT : VT;
            const int feat0 = (isk ? (pn - 4) : (pn - 8)) * BM;
            const int bb = u.pm >> 4; const int s0 = (u.pm & 15) * BM + wr * 64 + fr;
            const size_t bbase = (size_t)bb * (isk ? 1024 : 2048);
#pragma unroll
            for (int ai = 0; ai < 2; ++ai)
#pragma unroll
                for (int m = 0; m < 4; ++m) { const int s = s0 + ai * HALF + m * 16;
#pragma unroll
                    for (int bj = 0; bj < 2; ++bj)
#pragma unroll
                        for (int n = 0; n < 2; ++n)
#pragma unroll
                            for (int j = 0; j < 4; ++j) { const int feat = feat0 + bj * HALF + cl + 4 * n + j;
                                const unsigned w = cvt_pk_bf16(acc[ai][bj][m][n][j], 0.f);
                                base[(bbase + feat) * SEQ + s] = (bf16_t)(w & 0xffffu); } }
        }
    }
};
struct EpiVT {
    static constexpr bool PERM = false, NOSWAP = true, AFTER_DRAIN = false, HEADSCALE = false;
    bf16_t* VT;
    __device__ __forceinline__ void operator()(const AccT& acc, const Unit& u, int wr, int wc, int fr, int fq) const {
        const int bb = u.pm >> 4, s0 = (u.pm & 15) * BM + wr * 64 + 4 * fq, feat0 = u.pn * BM + wc * 32 + fr;
#pragma unroll
        for (int bj = 0; bj < 2; ++bj)
#pragma unroll
            for (int n = 0; n < 2; ++n) { bf16_t* fp = VT + ((size_t)bb * 2048 + feat0 + bj * HALF + n * 16) * SEQ + s0;
#pragma unroll
                for (int ai = 0; ai < 2; ++ai)
#pragma unroll
                    for (int m = 0; m < 4; ++m) { const f32x4 v = acc[ai][bj][m][n]; u32x2 w; w.x = cvt_pk_bf16(v[0], v[1]); w.y = cvt_pk_bf16(v[2], v[3]);
                        *(u32x2*)(fp + ai * HALF + m * 16) = w; } }
    }
};
struct EpiRgIn {
    static constexpr bool PERM = true, NOSWAP = false, AFTER_DRAIN = false, HEADSCALE = false;
    bf16_t *XB, *GB;
    __device__ __forceinline__ void operator()(const AccT& acc, const Unit& u, int wr, int wc, int fr, int fq) const {
        const int row0 = u.pm * BM + wr * 64 + fr; const bool isg = u.pn >= 8;
        bf16_t* base = isg ? GB : XB; const int col0 = (u.pn & 7) * BM + wc * 32 + 8 * fq;
#pragma unroll
        for (int ai = 0; ai < 2; ++ai)
#pragma unroll
            for (int m = 0; m < 4; ++m) { bf16_t* rowp = base + (size_t)(row0 + ai * HALF + m * 16) * DM + col0;
#pragma unroll
                for (int bj = 0; bj < 2; ++bj) { f32x4 v0 = acc[ai][bj][m][0], v1 = acc[ai][bj][m][1];
                    if (isg) {
#pragma unroll
                        for (int j = 0; j < 4; ++j) { float a = v0[j], b = v1[j];
                            const float ta = 1.5957691216057308f * (a + 0.044715f * a * a * a), tb = 1.5957691216057308f * (b + 0.044715f * b * b * b);
                            v0[j] = a * __builtin_amdgcn_rcpf(1.0f + __expf(-ta)); v1[j] = b * __builtin_amdgcn_rcpf(1.0f + __expf(-tb)); } }
                    u32x4 w; w.x = cvt_pk_bf16(v0[0], v0[1]); w.y = cvt_pk_bf16(v0[2], v0[3]); w.z = cvt_pk_bf16(v1[0], v1[1]); w.w = cvt_pk_bf16(v1[2], v1[3]);
                    *(u32x4*)(rowp + bj * HALF) = w; } }
    }
};
struct EpiGate {
    static constexpr bool PERM = false, NOSWAP = false, AFTER_DRAIN = false, HEADSCALE = false;
    const bf16_t* XC; const float *b_ra, *b_ri, *lam; unsigned* AU;
    __device__ __forceinline__ void operator()(const AccT& acc, const Unit& u, int wr, int wc, int fr, int fq) const {
        const int row0 = u.pm * BM + wr * 64 + fr, ch0 = u.pn * HALF + wc * 32 + 4 * fq;
#pragma unroll
        for (int n = 0; n < 2; ++n) {
            u32x2 xw[2][4];
#pragma unroll
            for (int ai = 0; ai < 2; ++ai)
#pragma unroll
                for (int m = 0; m < 4; ++m) xw[ai][m] = *(const u32x2*)(XC + (size_t)(row0 + ai * HALF + m * 16) * DM + ch0 + 16 * n);
            const f32x4 bra = *(const f32x4*)(b_ra + ch0 + 16 * n), bri = *(const f32x4*)(b_ri + ch0 + 16 * n), l = *(const f32x4*)(lam + ch0 + 16 * n);
            f32x4 sp;
#pragma unroll
            for (int j = 0; j < 4; ++j) sp[j] = -8.0f * log1pf(__expf(-l[j]));
#pragma unroll
            for (int ai = 0; ai < 2; ++ai)
#pragma unroll
                for (int m = 0; m < 4; ++m) { const size_t off = (size_t)(row0 + ai * HALF + m * 16) * DM + ch0 + 16 * n;
                    const f32x4 rp = acc[ai][0][m][n] + bra, ip = acc[ai][1][m][n] + bri;
                    const u32x2 w = xw[ai][m]; const float xv[4] = {bf_lo(w.x), bf_hi(w.x), bf_lo(w.y), bf_hi(w.y)};
                    u32x4 o;
#pragma unroll
                    for (int j = 0; j < 4; ++j) { const float r = __builtin_amdgcn_rcpf(1.0f + __expf(-rp[j])), ig = __builtin_amdgcn_rcpf(1.0f + __expf(-ip[j])); const float la = sp[j] * r; const float d = 1.0f - __expf(la);
                        o[j] = cvt_pk_bf16(d, __builtin_amdgcn_sqrtf(fmaxf(d * (2.0f - d), 0.f)) * (ig * xv[j])); }
                    *(u32x4*)(AU + off) = o; }
        }
    }
};

__device__ __forceinline__ void transpose_item(const float* src, int ldsrc, bf16_t* dst, int lddst, int kt, int ntile, LAS float* scr, int lane, const float* kscale = nullptr) {
    const int k0 = kt * 64, n0 = ntile * 64, l16 = lane & 15, l4 = lane >> 4;
    f32x4 tv[16];
#pragma unroll
    for (int i = 0; i < 16; ++i) tv[i] = *(const f32x4*)(src + (size_t)(k0 + l4 + 4 * i) * ldsrc + n0 + 4 * l16);
    if (kscale) {
#pragma unroll
        for (int i = 0; i < 16; ++i) tv[i] *= kscale[k0 + l4 + 4 * i];
    }
#pragma unroll
    for (int i = 0; i < 16; ++i) { const int kk = l4 + 4 * i; const f32x4 v = tv[i];
        LAS float* d = scr + kk * 65 + 4 * l16; d[0] = v[0]; d[1] = v[1]; d[2] = v[2]; d[3] = v[3]; }
    LDS_FENCE();
    const int c = lane & 7;
#pragma unroll
    for (int j = 0; j < 8; ++j) { const int n = (lane >> 3) + 8 * j; const LAS float* s = scr + (8 * c) * 65 + n;
        u32x4 o; o.x = cvt_pk_bf16(s[0], s[65]); o.y = cvt_pk_bf16(s[2 * 65], s[3 * 65]); o.z = cvt_pk_bf16(s[4 * 65], s[5 * 65]); o.w = cvt_pk_bf16(s[6 * 65], s[7 * 65]);
        *(u32x4*)(dst + (size_t)(n0 + n) * lddst + k0 + 8 * c) = o; }
    LDS_FENCE();
}
__device__ __forceinline__ void gemv_item(const Params& p, unsigned long long* MOD, int it, LAS float* scr, int lane) {
    const int mat = it / 1536, rem = it % 1536, cb = rem >> 6, ks = rem & 63, k0 = ks * 32, n0 = cb * 256 + 4 * lane;
#pragma unroll
    for (int i = 0; i < 2; ++i) { const int idx = lane + 64 * i, b = idx >> 5, kk = idx & 31; const float cv = p.c[b * DM + k0 + kk]; scr[idx] = cv / (1.0f + __expf(-cv)); }
    LDS_FENCE();
    const float* W = p.ada_w + (size_t)mat * DM * 6144 + (size_t)k0 * 6144 + n0;
    f32x4 a0 = {0, 0, 0, 0}, a1 = a0, a2 = a0, a3 = a0;
#pragma unroll 16
    for (int kk = 0; kk < 32; ++kk) { const f32x4 w = *(const f32x4*)(W + (size_t)kk * 6144);
        a0 += w * scr[kk]; a1 += w * scr[32 + kk]; a2 += w * scr[64 + kk]; a3 += w * scr[96 + kk]; }
    if (ks == 0) { const f32x4 bv = *(const f32x4*)(p.ada_b + mat * 6144 + n0); a0 += bv; a1 += bv; a2 += bv; a3 += bv; }
    unsigned long long* o = MOD + (size_t)mat * 4 * 6144 + n0;
#pragma unroll
    for (int j = 0; j < 4; ++j) { atomicAdd(o + j, (unsigned long long)__float2ll_rn(a0[j] * 1099511627776.0f)); atomicAdd(o + 6144 + j, (unsigned long long)__float2ll_rn(a1[j] * 1099511627776.0f));
        atomicAdd(o + 2 * 6144 + j, (unsigned long long)__float2ll_rn(a2[j] * 1099511627776.0f)); atomicAdd(o + 3 * 6144 + j, (unsigned long long)__float2ll_rn(a3[j] * 1099511627776.0f)); }
    LDS_FENCE();
}
__device__ __forceinline__ void phase0(const Params& p, LAS unsigned char* lds, const bool do_gemv = true) {
    const int tid = opaque_tid(), lane = tid & 63, wave = __builtin_amdgcn_readfirstlane(tid >> 6);
    const int G = gridDim.x, gw = blockIdx.x * 8 + wave, NGW = G * 8;
    LAS float* scr = (LAS float*)(lds + wave * 16640);
    unsigned char* ws = p.ws;
    { bf16_t* WG16 = (bf16_t*)(ws + OFF_WG16);
      for (int idx = blockIdx.x * 512 + tid; idx < 16 * 2048; idx += G * 512) { const int g = idx & 15, k = idx >> 4;
          const unsigned w = cvt_pk_bf16(p.a_w_in[(size_t)k * INA + 6144 + g], 0.f); WG16[g * 2048 + k] = (bf16_t)(w & 0xffffu); } }
    constexpr int I_GEMV = 6144, I_AIN = 32 * 96, I_SQ = 32 * 32, I_BIN = 32 * 64, I_MLP = 32 * 128, I_GATE = 256;
    constexpr int NITEMS = I_GEMV + I_AIN + 2 * I_SQ + I_BIN + 4 * I_MLP + I_GATE;
    unsigned long long* MOD = (unsigned long long*)(ws + OFF_MOD64);
    for (int it = gw; it < NITEMS; it += NGW) {
        int r = it;
        if (r < I_GEMV) { if (do_gemv) gemv_item(p, MOD, r, scr, lane); continue; } r -= I_GEMV;
        if (r < I_AIN) { transpose_item(p.a_w_in, INA, (bf16_t*)(ws + OFF_W_AIN), 2048, r / 96, r % 96, scr, lane); continue; } r -= I_AIN;
        if (r < I_SQ) { transpose_item(p.a_w_out, 2048, (bf16_t*)(ws + OFF_W_AOUT), 2048, r / 32, r % 32, scr, lane, p.a_norm_g); continue; } r -= I_SQ;
        if (r < I_SQ) { transpose_item(p.b_w_out, 2048, (bf16_t*)(ws + OFF_W_BOUT), 2048, r / 32, r % 32, scr, lane); continue; } r -= I_SQ;
        if (r < I_BIN) { transpose_item(p.b_w_in, 4096, (bf16_t*)(ws + OFF_W_BIN), 2048, r / 64, r % 64, scr, lane); continue; } r -= I_BIN;
        if (r < 2 * I_MLP) { const int l = r / I_MLP, q = r % I_MLP; transpose_item(p.mlp_w1 + (size_t)l * DM * DFF, DFF, (bf16_t*)(ws + OFF_W_1) + (size_t)l * DFF * DM, DM, q / 128, q % 128, scr, lane); continue; } r -= 2 * I_MLP;
        if (r < 2 * I_MLP) { const int l = r / I_MLP, q = r % I_MLP; transpose_item(p.mlp_w2 + (size_t)l * DM * DFF, DM, (bf16_t*)(ws + OFF_W_2) + (size_t)l * DFF * DM, DFF, q / 32, q % 32, scr, lane); continue; } r -= 2 * I_MLP;
        { const int sub = r >> 3, q = r & 7, kt = q >> 1, ntile = q & 1, nb = sub >> 2, gate = (sub >> 1) & 1, dh = sub & 1;
          const float* src = (gate ? p.b_w_ri : p.b_w_ra) + (size_t)nb * 65536 + dh * 128;
          bf16_t* dst = (bf16_t*)(ws + OFF_W_GATE) + (size_t)((nb * 2 + dh) * 256 + gate * 128) * 256;
          transpose_item(src, 256, dst, 256, kt, ntile, scr, lane); }
    }
}

__device__ __forceinline__ f32x4 ld_fx4(const unsigned long long* p) {
    const long long a = (long long)p[0], b = (long long)p[1], c = (long long)p[2], d = (long long)p[3];
    return (f32x4){(float)a, (float)b, (float)c, (float)d} * 9.094947017729282e-13f;
}
template <bool FINAL>
__device__ __forceinline__ void norm_phase(const float* X, const float* mod, bf16_t* H, const float* fg, float* OUT, const unsigned long long* acc64 = nullptr, float* modf = nullptr) {
    const int tid = opaque_tid(), lane = tid & 63, wave = tid >> 6;
    const int gw = blockIdx.x * 8 + wave, NGW = gridDim.x * 8;
    if (acc64) for (int i = blockIdx.x * 512 + tid; i < 4 * 4 * 6144; i += gridDim.x * 512) modf[i] = (float)(long long)acc64[i] * 9.094947017729282e-13f;
    for (int r = gw; r < MTOK; r += NGW) {
        const f32x4* xr = (const f32x4*)(X + (size_t)r * DM) + lane;
        f32x4 v[8]; float ss = 0.f;
#pragma unroll
        for (int j = 0; j < 8; ++j) { v[j] = xr[64 * j]; ss += (v[j][0] * v[j][0] + v[j][1] * v[j][1]) + (v[j][2] * v[j][2] + v[j][3] * v[j][3]); }
        const float rstd = rsqrtf(wave_sum(ss) * (1.0f / DM) + EPS);
        if (FINAL) {
#pragma unroll
            for (int j = 0; j < 8; ++j) { const f32x4 g = *((const f32x4*)fg + lane + 64 * j); *((f32x4*)(OUT + (size_t)r * DM) + lane + 64 * j) = v[j] * rstd * g; }
        } else {
            const float* mb = mod + (r >> 12) * 6144; const unsigned long long* mb64 = acc64 + (r >> 12) * 6144;
#pragma unroll
            for (int j = 0; j < 8; ++j) { const f32x4 sh = acc64 ? ld_fx4(mb64 + 4 * (lane + 64 * j)) : *((const f32x4*)mb + lane + 64 * j), sc = acc64 ? ld_fx4(mb64 + DM + 4 * (lane + 64 * j)) : *((const f32x4*)(mb + DM) + lane + 64 * j);
                const f32x4 o = v[j] * rstd * (sc + 1.0f) + sh; u32x2 w; w.x = cvt_pk_bf16(o[0], o[1]); w.y = cvt_pk_bf16(o[2], o[3]);
                *((u32x2*)(H + (size_t)r * DM) + lane + 64 * j) = w; }
        }
    }
}
template <bool FINAL>
__device__ __forceinline__ void norm_phase_b(const bf16_t* X, const float* mod, bf16_t* H, const float* fg, float* OUT) {
    const int tid = opaque_tid(), lane = tid & 63, wave = tid >> 6;
    const int gw = blockIdx.x * 8 + wave, NGW = gridDim.x * 8;
    for (int rb = gw; rb < MTOK / 2; rb += NGW) {
        u32x4 raw[2][4];
#pragma unroll
        for (int q = 0; q < 2; ++q)
#pragma unroll
            for (int j = 0; j < 4; ++j) raw[q][j] = *((const u32x4*)(X + (size_t)(2 * rb + q) * DM) + lane + 64 * j);
#pragma unroll
        for (int q = 0; q < 2; ++q) {
            const int r = 2 * rb + q;
            f32x4 v[4][2]; float ss = 0.f;
#pragma unroll
            for (int j = 0; j < 4; ++j) { const u32x4 w = raw[q][j];
                v[j][0] = (f32x4){bf_lo(w.x), bf_hi(w.x), bf_lo(w.y), bf_hi(w.y)}; v[j][1] = (f32x4){bf_lo(w.z), bf_hi(w.z), bf_lo(w.w), bf_hi(w.w)};
#pragma unroll
                for (int h = 0; h < 2; ++h) ss += (v[j][h][0] * v[j][h][0] + v[j][h][1] * v[j][h][1]) + (v[j][h][2] * v[j][h][2] + v[j][h][3] * v[j][h][3]); }
            const float rstd = rsqrtf(wave_sum(ss) * (1.0f / DM) + EPS);
            if (FINAL) {
#pragma unroll
                for (int j = 0; j < 4; ++j)
#pragma unroll
                    for (int h = 0; h < 2; ++h) { const int col = 8 * lane + 512 * j + 4 * h; const f32x4 g = *(const f32x4*)(fg + col); *(f32x4*)(OUT + (size_t)r * DM + col) = v[j][h] * rstd * g; }
            } else {
                const float* mb = mod + (r >> 12) * 6144;
#pragma unroll
                for (int j = 0; j < 4; ++j) { f32x4 o[2];
#pragma unroll
                    for (int h = 0; h < 2; ++h) { const int col = 8 * lane + 512 * j + 4 * h; const f32x4 sh = *(const f32x4*)(mb + col), sc = *(const f32x4*)(mb + DM + col); o[h] = v[j][h] * rstd * (sc + 1.0f) + sh; }
                    u32x4 w; w.x = cvt_pk_bf16(o[0][0], o[0][1]); w.y = cvt_pk_bf16(o[0][2], o[0][3]); w.z = cvt_pk_bf16(o[1][0], o[1][1]); w.w = cvt_pk_bf16(o[1][2], o[1][3]);
                    *((u32x4*)(H + (size_t)r * DM) + lane + 64 * j) = w; }
            }
        }
    }
}
__device__ __forceinline__ void headnorm_phase(const bf16_t* HH, const bf16_t* O, const float* ng, bf16_t* AB) {
    const int tid = opaque_tid(), lane = tid & 63, wave = tid >> 6;
    const int gw = blockIdx.x * 8 + wave, NGW = gridDim.x * 8;
    for (int r = gw; r < MTOK; r += NGW) {
        const u32x4* xr = (const u32x4*)(HH + (size_t)r * DM) + lane; const u32x4* orow = (const u32x4*)(O + (size_t)r * DM) + lane;
        u32x4 hv[4], ov[4];
#pragma unroll
        for (int j = 0; j < 4; ++j) { hv[j] = xr[64 * j]; ov[j] = orow[64 * j]; }
#pragma unroll
        for (int j = 0; j < 4; ++j) {
            const f32x4 v0 = {bf_lo(hv[j].x), bf_hi(hv[j].x), bf_lo(hv[j].y), bf_hi(hv[j].y)}, v1 = {bf_lo(hv[j].z), bf_hi(hv[j].z), bf_lo(hv[j].w), bf_hi(hv[j].w)};
            float ss = (v0[0] * v0[0] + v0[1] * v0[1]) + (v0[2] * v0[2] + v0[3] * v0[3]) + (v1[0] * v1[0] + v1[1] * v1[1]) + (v1[2] * v1[2] + v1[3] * v1[3]);
#pragma unroll
            for (int o = 1; o < 32; o <<= 1) ss += __shfl_xor(ss, o);
            const float rs = rsqrtf(ss * (1.0f / DV) + EPS);
            const int col = 8 * lane + 512 * j; const f32x4 g0 = *(const f32x4*)(ng + col), g1 = *(const f32x4*)(ng + col + 4);
            const f32x4 o0 = {bf_lo(ov[j].x), bf_hi(ov[j].x), bf_lo(ov[j].y), bf_hi(ov[j].y)}, o1 = {bf_lo(ov[j].z), bf_hi(ov[j].z), bf_lo(ov[j].w), bf_hi(ov[j].w)};
            f32x4 r0, r1;
#pragma unroll
            for (int q = 0; q < 4; ++q) { r0[q] = v0[q] * rs * g0[q] * sigmoidf_(o0[q]); r1[q] = v1[q] * rs * g1[q] * sigmoidf_(o1[q]); }
            u32x4 w; w.x = cvt_pk_bf16(r0[0], r0[1]); w.y = cvt_pk_bf16(r0[2], r0[3]); w.z = cvt_pk_bf16(r1[0], r1[1]); w.w = cvt_pk_bf16(r1[2], r1[3]);
            *((u32x4*)(AB + (size_t)r * DM) + lane + 64 * j) = w; }
    }
}

__device__ __forceinline__ float log_sigmoidf_(float x) { return fminf(x, 0.f) - log1pf(__expf(-fabsf(x))); }
__device__ __forceinline__ void gates_phase(const bf16_t* HB, const bf16_t* WG16, const float* bg, float* LI, float* LF) {
    const int tid = opaque_tid(), lane = tid & 63, wave = tid >> 6, fr = lane & 15, fq = lane >> 4;
    for (int rt = wave * gridDim.x + blockIdx.x; rt < MTOK / 16; rt += 8 * gridDim.x) {
        const bf16_t* ap = HB + (size_t)(rt * 16 + fr) * DM + 8 * fq; const bf16_t* bp = WG16 + fr * DM + 8 * fq;
        f32x4 acc = {0.f, 0.f, 0.f, 0.f};
#pragma unroll 16
        for (int kk = 0; kk < 64; ++kk) { const bf16x8 a = *(const bf16x8*)(ap + 32 * kk), b = *(const bf16x8*)(bp + 32 * kk);
            acc = __builtin_amdgcn_mfma_f32_16x16x32_bf16(a, b, acc, 0, 0, 0); }
        const int r0 = rt * 16 + 4 * fq, bb = r0 >> 12, s = r0 & 4095, g = fr & 7;
        const float bias = bg[fr];
        f32x4 o;
        if (fr < 8) { o = acc + bias; *(f32x4*)(LI + (size_t)(bb * 8 + g) * SEQ + s) = o; }
        else {
#pragma unroll
            for (int j = 0; j < 4; ++j) o[j] = log_sigmoidf_(acc[j] + bias);
            *(f32x4*)(LF + (size_t)(bb * 8 + g) * SEQ + s) = o; }
    }
}

constexpr int RS = 272;
constexpr int L_Q = 0, L_K = 34816, L_KT = 69632, L_VT = 104448, L_CT = 117504  , L_SC = 143616  ;
constexpr int SC_FLOATS = 656;
__device__ __forceinline__ void mlstm_phase(LAS unsigned char* lds, const bf16_t* Q, const bf16_t* Kn, const bf16_t* KT, const bf16_t* VT, const float* LI, const float* LF, bf16_t* HH, const bf16_t* O, float* SS) {
    const int tid = opaque_tid(), lane = tid & 63, w = __builtin_amdgcn_readfirstlane(tid >> 6), fr = lane & 15, fq = lane >> 4;
    for (int item = blockIdx.x; item < NBATCH * NH * 8; item += gridDim.x) {
        const int xcd = item & 7, slot = item >> 3, eb = slot & 7, bh = xcd * 4 + (slot >> 3), hh = bh & 7, bb = bh >> 3;
        WG_BARRIER();
        for (int i = tid; i < 2 * 13056 / 4; i += 512) *(LAS unsigned*)(lds + L_CT + 4 * i) = 0u;
        for (int i = tid; i < 16 * RS / 4; i += 512) *(LAS unsigned*)(lds + L_VT + 32 * RS + 4 * i) = (i < RS / 4) ? 0x3F803F80u : 0u;
        const bf16_t* gQ = Q + (size_t)bb * SEQ * 1024 + hh * 128;
        const bf16_t* gK = Kn + (size_t)bb * SEQ * 1024 + hh * 128;
        const bf16_t* gKT = KT + (size_t)(bb * 8 + hh) * 128 * SEQ;
        const bf16_t* gVT = VT + ((size_t)(bb * 8 + hh) * 256 + eb * 32) * SEQ;
        const float* gLI = LI + (size_t)(bb * 8 + hh) * SEQ; const float* gLF = LF + (size_t)(bb * 8 + hh) * SEQ;
        bf16_t* gH = HH + (size_t)bb * SEQ * DM + hh * 256 + eb * 32;
        const bf16_t* gO = O + (size_t)bb * SEQ * DM + hh * 256 + eb * 32;
        float* gSS = SS + (size_t)bb * SEQ * 64 + hh * 8 + eb;
        u32x4 ro;
        u32x4 rq[4], rk[4], rkt[4], rvt; f32x2 rli = {0.f, 0.f}, rlf = {0.f, 0.f};
        const int prow = tid >> 4, pseg = tid & 15;
        float m_prev = 0.f;
#define ML_LOAD(c_) do { const int s0_ = (c_) * CH; \
            _Pragma("unroll") for (int i = 0; i < 4; ++i) { const int row = prow + 32 * i; \
                rq[i] = *(const u32x4*)(gQ + (size_t)(s0_ + row) * 1024 + pseg * 8); rk[i] = *(const u32x4*)(gK + (size_t)(s0_ + row) * 1024 + pseg * 8); \
                rkt[i] = *(const u32x4*)(gKT + (size_t)row * SEQ + s0_ + pseg * 8); } \
            rvt = *(const u32x4*)(gVT + (size_t)prow * SEQ + s0_ + pseg * 8); \
            ro = *(const u32x4*)(gO + (size_t)(s0_ + (tid >> 2)) * DM + (tid & 3) * 8); } while (0)
#define ML_LOADG(c_) do { rli = *(const f32x2*)(gLI + (c_) * CH + 2 * lane); rlf = *(const f32x2*)(gLF + (c_) * CH + 2 * lane); } while (0)
#define ML_SCALARS(sb_) do { LAS float* sA_ = (LAS float*)(lds + L_SC + (sb_) * (SC_FLOATS * 4)); \
            const float c1 = rlf[0] + rlf[1]; float incl = c1; \
            _Pragma("unroll") for (int o = 1; o < 64; o <<= 1) { const float t = __shfl_up(incl, o); if (lane >= o) incl += t; } \
            const float b1 = incl, b0 = incl - rlf[1]; const float a0 = rli[0] - b0, a1 = rli[1] - b1; float im = fmaxf(a0, a1); \
            _Pragma("unroll") for (int o = 1; o < 64; o <<= 1) { const float t = __shfl_up(im, o); if (lane >= o) im = fmaxf(im, t); } \
            float ex = __shfl_up(im, 1); if (lane == 0) ex = -INFINITY; \
            const float mx0 = fmaxf(m_prev, fmaxf(ex, a0)), mx1 = fmaxf(m_prev, im); const float mxl = __shfl(mx1, 63), bl = __shfl(b1, 63); \
            *(LAS f32x2*)(sA_ + 2 * lane) = (f32x2){a0, a1}; *(LAS f32x2*)(sA_ + 128 + 2 * lane) = (f32x2){mx0, mx1}; *(LAS f32x2*)(sA_ + 256 + 2 * lane) = (f32x2){b0, b1}; \
            *(LAS f32x2*)(sA_ + 384 + 2 * lane) = (f32x2){__expf(a0 - mxl), __expf(a1 - mxl)}; \
            if (lane == 0) { sA_[512] = m_prev; sA_[513] = mxl; sA_[514] = __expf(m_prev - mxl); } \
            m_prev = bl + mxl; } while (0)
        ML_LOAD(0);
        if (w == 0) { ML_LOADG(0); ML_SCALARS(0); ML_LOADG(1); }
        f32x4 accC[2][3];
#pragma unroll
        for (int dd = 0; dd < 2; ++dd)
#pragma unroll
            for (int e3 = 0; e3 < 3; ++e3) accC[dd][e3] = (f32x4){0.f, 0.f, 0.f, 0.f};
        for (int c = 0; c < NCHUNK; ++c) {
            const int sb = c & 1;
            LAS float* sA = (LAS float*)(lds + L_SC + sb * (SC_FLOATS * 4)); LAS float* sMx = sA + 128; LAS float* sB = sA + 256; LAS float* sWk = sA + 384; LAS float* sMisc = sA + 512;
            WG_BARRIER();
            {
                const f32x4 wk0 = *(const LAS f32x4*)(sWk + pseg * 8), wk1 = *(const LAS f32x4*)(sWk + pseg * 8 + 4);
#pragma unroll
                for (int i = 0; i < 4; ++i) { const int row = prow + 32 * i;
                    *(LAS u32x4*)(lds + L_Q + row * RS + pseg * 16) = rq[i]; *(LAS u32x4*)(lds + L_K + row * RS + pseg * 16) = rk[i];
                    const u32x4 v = rkt[i]; u32x4 o;
                    o.x = cvt_pk_bf16(bf_lo(v.x) * wk0[0], bf_hi(v.x) * wk0[1]); o.y = cvt_pk_bf16(bf_lo(v.y) * wk0[2], bf_hi(v.y) * wk0[3]);
                    o.z = cvt_pk_bf16(bf_lo(v.z) * wk1[0], bf_hi(v.z) * wk1[1]); o.w = cvt_pk_bf16(bf_lo(v.w) * wk1[2], bf_hi(v.w) * wk1[3]);
                    *(LAS u32x4*)(lds + L_KT + row * RS + pseg * 16) = o; }
                *(LAS u32x4*)(lds + L_VT + prow * RS + pseg * 16) = rvt;
                *(LAS u32x4*)(lds + L_HS + (tid >> 2) * HS_RS + (tid & 3) * 16) = ro;
            }
            WG_BARRIER_LDS();
            if (c + 1 < NCHUNK) ML_LOAD(c + 1);
            if (w == 0 && c + 1 < NCHUNK) { ML_SCALARS(sb ^ 1); if (c + 2 < NCHUNK) ML_LOADG(c + 2); }
            bf16x8 qf[4];
#pragma unroll
            for (int kk = 0; kk < 4; ++kk) qf[kk] = *(const LAS bf16x8*)(lds + L_Q + (16 * w + fr) * RS + (32 * kk + 8 * fq) * 2);
            f32x4 acc2[3] = {{0.f, 0.f, 0.f, 0.f}, {0.f, 0.f, 0.f, 0.f}, {0.f, 0.f, 0.f, 0.f}};
            const int ctb = L_CT + sb * 13056;
#pragma unroll
            for (int kk = 0; kk < 4; ++kk)
#pragma unroll
                for (int e3 = 0; e3 < 3; ++e3) { const bf16x8 cf = *(const LAS bf16x8*)(lds + ctb + (16 * e3 + fr) * RS + (32 * kk + 8 * fq) * 2);
                    acc2[e3] = __builtin_amdgcn_mfma_f32_16x16x32_bf16(qf[kk], cf, acc2[e3], 0, 0, 0); }
            const float mp = sMisc[0];
            const f32x4 mx4 = *(const LAS f32x4*)(sMx + 16 * w + 4 * fq), b4 = *(const LAS f32x4*)(sB + 16 * w + 4 * fq);
            {
                f32x4 wi;
#pragma unroll
                for (int j = 0; j < 4; ++j) wi[j] = __expf(mp - mx4[j]);
#pragma unroll
                for (int e3 = 0; e3 < 3; ++e3) acc2[e3] *= wi;
            }
            const int tl = 16 * w + fr; const float mxt = sMx[tl];
#pragma unroll
            for (int kk = 0; kk < 4; ++kk) {
                if (2 * kk <= w) {
                    unsigned pw[4] = {0u, 0u, 0u, 0u};
#pragma unroll
                    for (int h = 0; h < 2; ++h) { const int i = 2 * kk + h;
                        if (i <= w) { f32x4 sacc = {0.f, 0.f, 0.f, 0.f};
#pragma unroll
                            for (int k2 = 0; k2 < 4; ++k2) { const bf16x8 kf = *(const LAS bf16x8*)(lds + L_K + (16 * i + fr) * RS + (32 * k2 + 8 * fq) * 2);
                                sacc = __builtin_amdgcn_mfma_f32_16x16x32_bf16(kf, qf[k2], sacc, 0, 0, 0); }
                            const f32x4 av = *(const LAS f32x4*)(sA + 16 * i + 4 * fq); float pv[4];
#pragma unroll
                            for (int j = 0; j < 4; ++j) { const int sidx = 16 * i + 4 * fq + j; pv[j] = (sidx <= tl) ? sacc[j] * __expf(av[j] - mxt) : 0.f; }
                            pw[2 * h] = cvt_pk_bf16(pv[0], pv[1]); pw[2 * h + 1] = cvt_pk_bf16(pv[2], pv[3]); } }
                    const bf16x8 pf = __builtin_bit_cast(bf16x8, (u32x4){pw[0], pw[1], pw[2], pw[3]});
#pragma unroll
                    for (int e3 = 0; e3 < 3; ++e3) { const LAS unsigned char* vp = lds + L_VT + (16 * e3 + fr) * RS + (32 * kk + 4 * fq) * 2;
                        const u32x2 v0 = *(const LAS u32x2*)vp, v1 = *(const LAS u32x2*)(vp + 32);
                        const bf16x8 vf = __builtin_bit_cast(bf16x8, (u32x4){v0.x, v0.y, v1.x, v1.y});
                        acc2[e3] = __builtin_amdgcn_mfma_f32_16x16x32_bf16(pf, vf, acc2[e3], 0, 0, 0); }
                }
            }
            {
                const int s0 = c * CH;
#pragma unroll
                for (int j = 0; j < 4; ++j) { const float den = __shfl(acc2[2][j], lane & 48); const float thr = __expf(-(b4[j] + mx4[j]));
                    const float inv = 1.0f / fmaxf(fabsf(den), thr); const int tr = 16 * w + 4 * fq + j; bf16_t* hp = gH + (size_t)(s0 + tr) * DM + fr;
                    const float h0 = acc2[0][j] * inv, h1 = acc2[1][j] * inv;
                    float ps = h0 * h0 + h1 * h1;
                    ps += __shfl_xor(ps, 1); ps += __shfl_xor(ps, 2); ps += __shfl_xor(ps, 4); ps += __shfl_xor(ps, 8);
                    if (fr == 0) gSS[(size_t)(s0 + tr) * 64] = ps;
                    const LAS bf16_t* so = (const LAS bf16_t*)(lds + L_HS + tr * HS_RS);
                    const float o0 = __uint_as_float((unsigned)so[fr] << 16), o1 = __uint_as_float((unsigned)so[16 + fr] << 16);
                    const unsigned hw = cvt_pk_bf16(h0 * sigmoidf_(o0), h1 * sigmoidf_(o1)); hp[0] = (bf16_t)(hw & 0xffffu); hp[16] = (bf16_t)(hw >> 16); }
            }
            if (w < 4) {
                const float decay = sMisc[2];
                const int ctn = L_CT + (sb ^ 1) * 13056;
                bf16x8 vf[4][3];
#pragma unroll
                for (int kk = 0; kk < 4; ++kk)
#pragma unroll
                    for (int e3 = 0; e3 < 3; ++e3) vf[kk][e3] = *(const LAS bf16x8*)(lds + L_VT + (16 * e3 + fr) * RS + (32 * kk + 8 * fq) * 2);
#pragma unroll
                for (int dd = 0; dd < 2; ++dd) { const int dt = w + 4 * dd;
#pragma unroll
                    for (int e3 = 0; e3 < 3; ++e3) accC[dd][e3] *= decay;
#pragma unroll
                    for (int kk = 0; kk < 4; ++kk) { const bf16x8 kf = *(const LAS bf16x8*)(lds + L_KT + (16 * dt + fr) * RS + (32 * kk + 8 * fq) * 2);
#pragma unroll
                        for (int e3 = 0; e3 < 3; ++e3) accC[dd][e3] = __builtin_amdgcn_mfma_f32_16x16x32_bf16(kf, vf[kk][e3], accC[dd][e3], 0, 0, 0); }
#pragma unroll
                    for (int e3 = 0; e3 < 3; ++e3) { u32x2 o; o.x = cvt_pk_bf16(accC[dd][e3][0], accC[dd][e3][1]); o.y = cvt_pk_bf16(accC[dd][e3][2], accC[dd][e3][3]);
                        *(LAS u32x2*)(lds + ctn + (16 * e3 + fr) * RS + (16 * dt + 4 * fq) * 2) = o; } }
            }
        }
#undef ML_LOAD
#undef ML_LOADG
#undef ML_SCALARS
    }
    WG_BARRIER();
}

__device__ __forceinline__ void conv_item(const bf16_t* XB, const float* cw, const float* cb, bf16_t* XC, int idx) {
    const int r = idx >> 8, ch = (idx & 255) * 8, t = r & (SEQ - 1);
    u32x4 xv[4];
#pragma unroll
    for (int wv = 0; wv < 4; ++wv) { const int tt = t - 3 + wv; xv[wv] = (tt >= 0) ? *(const u32x4*)(XB + (size_t)(r - 3 + wv) * DM + ch) : (u32x4){0u, 0u, 0u, 0u}; }
    float acc[8];
    { const f32x4 b0 = *(const f32x4*)(cb + ch), b1 = *(const f32x4*)(cb + ch + 4);
#pragma unroll
      for (int j = 0; j < 4; ++j) { acc[j] = b0[j]; acc[4 + j] = b1[j]; } }
#pragma unroll
    for (int wv = 0; wv < 4; ++wv) { const f32x4 w0 = *(const f32x4*)(cw + wv * DM + ch), w1 = *(const f32x4*)(cw + wv * DM + ch + 4); const u32x4 x = xv[wv];
        acc[0] += w0[0] * bf_lo(x.x); acc[1] += w0[1] * bf_hi(x.x); acc[2] += w0[2] * bf_lo(x.y); acc[3] += w0[3] * bf_hi(x.y);
        acc[4] += w1[0] * bf_lo(x.z); acc[5] += w1[1] * bf_hi(x.z); acc[6] += w1[2] * bf_lo(x.w); acc[7] += w1[3] * bf_hi(x.w); }
    u32x4 o; o.x = cvt_pk_bf16(acc[0], acc[1]); o.y = cvt_pk_bf16(acc[2], acc[3]); o.z = cvt_pk_bf16(acc[4], acc[5]); o.w = cvt_pk_bf16(acc[6], acc[7]);
    *(u32x4*)(XC + (size_t)r * DM + ch) = o;
}
__device__ __forceinline__ void conv_own_tiles(const bf16_t* XB, const float* cw, const float* cb, bf16_t* XC) {
    const int tid = opaque_tid(), cg = tid & 31, rb = tid >> 5;
    StaticOrder S; S.init(MTOK, 4096, gridDim.x, blockIdx.x);
    for (int i = 0; ; ++i) {
        Unit u; if (!S.next(i, u)) break;
        if (u.pn >= 8) continue;
        const int ch = u.pn * 256 + cg * 8; const size_t row0 = (size_t)u.pm * 256 + rb * 16;
        f32x4 w0[4], w1[4];
#pragma unroll
        for (int wv = 0; wv < 4; ++wv) { w0[wv] = *(const f32x4*)(cw + wv * DM + ch); w1[wv] = *(const f32x4*)(cw + wv * DM + ch + 4); }
        const f32x4 b0 = *(const f32x4*)(cb + ch), b1 = *(const f32x4*)(cb + ch + 4);
        u32x4 xr[19];
#pragma unroll
        for (int k = 0; k < 19; ++k) xr[k] = (rb == 0 && k < 3) ? (u32x4){0u, 0u, 0u, 0u} : *(const u32x4*)(XB + (row0 + k - 3) * DM + ch);
#pragma unroll
        for (int r = 0; r < 16; ++r) {
            if (rb == 0 && r < 3) continue;
            f32x4 a0 = b0, a1 = b1;
#pragma unroll
            for (int wv = 0; wv < 4; ++wv) { const u32x4 x = xr[r + wv];
                a0 += w0[wv] * (f32x4){bf_lo(x.x), bf_hi(x.x), bf_lo(x.y), bf_hi(x.y)}; a1 += w1[wv] * (f32x4){bf_lo(x.z), bf_hi(x.z), bf_lo(x.w), bf_hi(x.w)}; }
            u32x4 o; o.x = cvt_pk_bf16(a0[0], a0[1]); o.y = cvt_pk_bf16(a0[2], a0[3]); o.z = cvt_pk_bf16(a1[0], a1[1]); o.w = cvt_pk_bf16(a1[2], a1[3]);
            *(u32x4*)(XC + (row0 + r) * DM + ch) = o; }
    }
}
__device__ __forceinline__ void conv_halo_rows(const bf16_t* XB, const float* cw, const float* cb, bf16_t* XC) {
    const int tid = opaque_tid();
    StaticOrder S; S.init(MTOK, 4096, gridDim.x, blockIdx.x);
    for (int i0 = 0; ; i0 += 4) {
        Unit u; if (!S.next(i0, u)) break;
        const int ui = i0 + tid / 96, rem = tid % 96;
        if (tid < 384 && S.next(ui, u)) { const int r = u.pm * 256 + (rem >> 5); conv_item(XB, cw, cb, XC, r * 256 + (u.pn >> 1) * 32 + (rem & 31)); }
    }
    asm volatile("s_waitcnt vmcnt(0)" ::: "memory");
    __syncthreads();
}
__device__ __forceinline__ void conv_phase(const bf16_t* XB, const float* cw, const float* cb, bf16_t* XC) {
    const int G = gridDim.x, rows_per = (MTOK + G - 1) / G, r0 = blockIdx.x * rows_per, r1 = min(MTOK, r0 + rows_per);
    const int tid = opaque_tid();
#pragma unroll 4
    for (int idx = r0 * 256 + tid; idx < r1 * 256; idx += 512) conv_item(XB, cw, cb, XC, idx);
}
__device__ __forceinline__ void scan1_phase(const unsigned* AU, float* PA, float* PH) {
    const int nth = gridDim.x * 512;
    for (int idx = blockIdx.x * 512 + opaque_tid(); idx < NBATCH * SCH * 1024; idx += nth) {
        const int ch = (idx & 1023) * 2, cc = (idx >> 10) & (SCH - 1), bb = idx >> 15;
        const size_t base = (size_t)(bb * SEQ + cc * SCL) * DM + ch;
        float h0 = 0.f, h1 = 0.f, p0 = 1.f, p1 = 1.f;
#pragma unroll 16
        for (int t = 0; t < SCL; ++t) { const u32x2 w = *(const u32x2*)(AU + base + (size_t)t * DM);
            const float a0 = 1.0f - bf_lo(w.x), a1 = 1.0f - bf_lo(w.y);
            h0 = a0 * h0 + bf_hi(w.x); h1 = a1 * h1 + bf_hi(w.y); p0 *= a0; p1 *= a1; }
        const size_t o = (size_t)(bb * SCH + cc) * DM + ch;
        *(f32x2*)(PA + o) = (f32x2){p0, p1}; *(f32x2*)(PH + o) = (f32x2){h0, h1};
    }
}
__device__ __forceinline__ void scan1_own_tiles(const unsigned* AU, float* PA, float* PH) {
    const int tid = opaque_tid();
    StaticOrder S; S.init(MTOK, 4096, gridDim.x, blockIdx.x);
    for (int i0 = 0; ; i0 += 4) {
        Unit u; const int ui = i0 + (tid >> 7);
        if (!S.next(i0, u)) break;
        if (S.next(ui, u)) {
            const int half = (tid >> 6) & 1, pair = tid & 63, ch = u.pn * 128 + 2 * pair;
            const int bb = u.pm >> 4, cc = (u.pm & 15) * 2 + half;
            const size_t base = (size_t)(u.pm * 256 + half * SCL) * DM + ch;
            float h0 = 0.f, h1 = 0.f, p0 = 1.f, p1 = 1.f;
#pragma unroll 16
            for (int t = 0; t < SCL; ++t) { const u32x2 w = *(const u32x2*)(AU + base + (size_t)t * DM);
                const float a0 = 1.0f - bf_lo(w.x), a1 = 1.0f - bf_lo(w.y);
                h0 = a0 * h0 + bf_hi(w.x); h1 = a1 * h1 + bf_hi(w.y); p0 *= a0; p1 *= a1; }
            const size_t o = (size_t)(bb * SCH + cc) * DM + ch;
            *(f32x2*)(PA + o) = (f32x2){p0, p1}; *(f32x2*)(PH + o) = (f32x2){h0, h1};
        }
    }
}
__device__ __forceinline__ void scan2_phase(const unsigned* AU, const float* PA, const float* PH, const bf16_t* GB, bf16_t* AB) {
    const int nth = gridDim.x * 512;
    for (int idx = blockIdx.x * 512 + opaque_tid(); idx < NBATCH * SCH * 1024; idx += nth) {
        const int ch = (idx & 1023) * 2, cc = (idx >> 10) & (SCH - 1), bb = idx >> 15;
        float h0 = 0.f, h1 = 0.f;
        for (int q = 0; q < cc; ++q) { const size_t o = (size_t)(bb * SCH + q) * DM + ch; const f32x2 pa = *(const f32x2*)(PA + o), ph = *(const f32x2*)(PH + o);
            h0 = pa[0] * h0 + ph[0]; h1 = pa[1] * h1 + ph[1]; }
        const size_t base = (size_t)(bb * SEQ + cc * SCL) * DM + ch;
#pragma unroll 16
        for (int t = 0; t < SCL; ++t) { const u32x2 w = *(const u32x2*)(AU + base + (size_t)t * DM);
            const unsigned g = *(const unsigned*)(GB + base + (size_t)t * DM);
            h0 = (1.0f - bf_lo(w.x)) * h0 + bf_hi(w.x); h1 = (1.0f - bf_lo(w.y)) * h1 + bf_hi(w.y);
            *(unsigned*)(AB + base + (size_t)t * DM) = cvt_pk_bf16(h0 * bf_lo(g), h1 * bf_hi(g)); }
    }
}

__device__ __forceinline__ void build_head_scale_table(LAS unsigned char* lds, const float* SS, const int round) {
    const int tid = opaque_tid();
    if (tid < 256) {
        const int c = blockIdx.x, pm = 32 * round + 4 * (c & 7) + (c >> 6);
        const f32x4* sp = (const f32x4*)(SS + ((size_t)pm * 256 + tid) * 64);
        LAS float* rt = (LAS float*)(lds + L_RT) + tid * 8;
        float prev = 0.f;
#pragma unroll 1
        for (int h = 0; h < 8; ++h) { const f32x4 a = sp[2 * h], b = sp[2 * h + 1];
            const float ms = (((a[0] + a[1]) + (a[2] + a[3])) + ((b[0] + b[1]) + (b[2] + b[3]))) * (1.0f / DV) + EPS;
            if (h > 0) rt[h - 1] = prev * sqrtf(ms);
            prev = rsqrtf(ms); }
        rt[7] = prev;
    }
    WG_BARRIER_LDS();
}
__device__ __forceinline__ void mlp_block(const Params& p, LAS unsigned char* lds, const XcdBarrier& xb, const int layer) {
    unsigned char* ws = p.ws;
    bf16_t* XR = (bf16_t*)(ws + OFF_XR);
    const float* MODp = (const float*)(ws + OFF_MOD);
    const float* mod = MODp + (layer * 2 + 1) * 4 * 6144;
    { EpiSqRelu e{(bf16_t*)(ws + SM_U)};
      gemm_phase(lds, (const bf16_t*)(ws + SM_HB), DM, (const bf16_t*)(ws + OFF_W_1) + (size_t)layer * DFF * DM, DM, MTOK, DFF, DM, 0, e); }
    xcd_barrier(xb);
    const bf16_t* A = (const bf16_t*)(ws + SM_U); const bf16_t* B = (const bf16_t*)(ws + OFF_W_2) + (size_t)layer * DFF * DM;
    unsigned* X = (unsigned*)(ws + OFF_XCH + (size_t)(layer == 0 ? 1 : 3) * SZ_XCH1); unsigned* cnt = (unsigned*)(ws + OFF_CNT) + (layer == 0 ? 1 : 3) * 64 * 64;
    if (layer == 0) {
        EpiResidNorm<false, false> e{XR, XR, mod + 4096, MODp + 2 * 4 * 6144, (bf16_t*)(ws + S1_HB), nullptr, nullptr, X, cnt};
        gemm_phase(lds, A, DFF, B, DFF, MTOK, DM, DFF, 0, e, 0);
        gemm_phase(lds, A, DFF, B, DFF, MTOK, DM, DFF, 0, e, 1);
        xcd_barrier(xb);
    } else {
        EpiResidNorm<false, true> e{XR, nullptr, mod + 4096, nullptr, nullptr, p.final_g, p.out, X, cnt};
        gemm_phase(lds, A, DFF, B, DFF, MTOK, DM, DFF, 0, e, 0);
        gemm_phase(lds, A, DFF, B, DFF, MTOK, DM, DFF, 0, e, 1);
    }
}
__global__ void __launch_bounds__(512) mega_fwd(Params p) {
    extern __shared__ __attribute__((aligned(16))) unsigned char smem[];
    LAS unsigned char* lds = (LAS unsigned char*)smem;
    unsigned char* ws = p.ws;
    if (ws == nullptr) cg::this_grid().sync();
    volatile LAS unsigned* xst = (volatile LAS unsigned*)(lds + L_XB);
    if (threadIdx.x < 4) xst[threadIdx.x] = 0u;
    __syncthreads();
    const XcdBarrier xb = xcd_barrier_post((unsigned*)(ws + OFF_BAR), xst);
    float* MOD = (float*)(ws + OFF_MOD);
    bf16_t* XR = (bf16_t*)(ws + OFF_XR);

    phase0(p, lds);
    xcd_barrier(xb);
    norm_phase<false>(p.x, MOD + 0 * 4 * 6144, (bf16_t*)(ws + S0_HB), nullptr, nullptr, (const unsigned long long*)(ws + OFF_MOD64), MOD);
    xcd_barrier(xb);
    gates_phase((const bf16_t*)(ws + S0_HB), (const bf16_t*)(ws + OFF_WG16), p.a_b_gate, (float*)(ws + OFF_LI), (float*)(ws + OFF_LF));
    { EpiProj e{(bf16_t*)(ws + S0_Q), (bf16_t*)(ws + S0_K), (bf16_t*)(ws + S0_KT), (bf16_t*)(ws + S0_VT), (bf16_t*)(ws + S0_O), 0};
      gemm_phase(lds, (const bf16_t*)(ws + S0_HB), DM, (const bf16_t*)(ws + OFF_W_AIN), DM, MTOK, 2048, DM, 0, e); }
    { EpiVT e{(bf16_t*)(ws + S0_VT)};
      gemm_phase(lds, (const bf16_t*)(ws + S0_HB), DM, (const bf16_t*)(ws + OFF_W_AIN) + (size_t)2048 * DM, DM, MTOK, 2048, DM, 0, e); }
    { EpiProj e{(bf16_t*)(ws + S0_Q), (bf16_t*)(ws + S0_K), (bf16_t*)(ws + S0_KT), (bf16_t*)(ws + S0_VT), (bf16_t*)(ws + S0_O), 16};
      gemm_phase(lds, (const bf16_t*)(ws + S0_HB), DM, (const bf16_t*)(ws + OFF_W_AIN) + (size_t)4096 * DM, DM, MTOK, 2048, DM, 0, e); }
    xcd_barrier(xb);
    mlstm_phase(lds, (const bf16_t*)(ws + S0_Q), (const bf16_t*)(ws + S0_K), (const bf16_t*)(ws + S0_KT), (const bf16_t*)(ws + S0_VT), (const float*)(ws + OFF_LI), (const float*)(ws + OFF_LF),
                (bf16_t*)(ws + S0_AB), (const bf16_t*)(ws + S0_O), (float*)(ws + OFF_SS));
    xcd_barrier(xb);
    build_head_scale_table(lds, (const float*)(ws + OFF_SS), 0);
    { EpiResidNorm<true, false> e{p.x, XR, MOD + 0 * 4 * 6144 + 4096, MOD + 1 * 4 * 6144, (bf16_t*)(ws + SM_HB), nullptr, nullptr, (unsigned*)(ws + OFF_XCH), (unsigned*)(ws + OFF_CNT)};
      gemm_phase(lds, (const bf16_t*)(ws + S0_AB), DM, (const bf16_t*)(ws + OFF_W_AOUT), DM, MTOK, DM, DM, 0, e, 0); }
    build_head_scale_table(lds, (const float*)(ws + OFF_SS), 1);
    { EpiResidNorm<true, false> e{p.x, XR, MOD + 0 * 4 * 6144 + 4096, MOD + 1 * 4 * 6144, (bf16_t*)(ws + SM_HB), nullptr, nullptr, (unsigned*)(ws + OFF_XCH), (unsigned*)(ws + OFF_CNT)};
      gemm_phase(lds, (const bf16_t*)(ws + S0_AB), DM, (const bf16_t*)(ws + OFF_W_AOUT), DM, MTOK, DM, DM, 0, e, 1); }
    xcd_barrier(xb);
    mlp_block(p, lds, xb, 0);
    { EpiRgIn e{(bf16_t*)(ws + S1_XB), (bf16_t*)(ws + S1_GB)};
      gemm_phase(lds, (const bf16_t*)(ws + S1_HB), DM, (const bf16_t*)(ws + OFF_W_BIN), DM, MTOK, 4096, DM, 0, e); }
    conv_own_tiles((const bf16_t*)(ws + S1_XB), p.b_conv_w, p.b_conv_b, (bf16_t*)(ws + S1_XC));
    xcd_barrier(xb);
    conv_halo_rows((const bf16_t*)(ws + S1_XB), p.b_conv_w, p.b_conv_b, (bf16_t*)(ws + S1_XC));
    { EpiGate e{(const bf16_t*)(ws + S1_XC), p.b_b_ra, p.b_b_ri, p.b_lam, (unsigned*)(ws + S1_A)};
      gemm_phase(lds, (const bf16_t*)(ws + S1_XC), DM, (const bf16_t*)(ws + OFF_W_GATE), 256, MTOK, 4096, 256, 1, e); }
    scan1_own_tiles((const unsigned*)(ws + S1_A), (float*)(ws + OFF_SCAN), (float*)(ws + OFF_SCAN) + NBATCH * SCH * DM);
    xcd_barrier(xb);
    scan2_phase((const unsigned*)(ws + S1_A), (const float*)(ws + OFF_SCAN), (const float*)(ws + OFF_SCAN) + NBATCH * SCH * DM, (const bf16_t*)(ws + S1_GB), (bf16_t*)(ws + S1_AB));
    xcd_barrier(xb);
    { EpiResidNorm<false, false> e{XR, XR, MOD + 2 * 4 * 6144 + 4096, MOD + 3 * 4 * 6144, (bf16_t*)(ws + SM_HB), nullptr, nullptr, (unsigned*)(ws + OFF_XCH + 2 * SZ_XCH1), (unsigned*)(ws + OFF_CNT) + 2 * 64 * 64};
      gemm_phase(lds, (const bf16_t*)(ws + S1_AB), DM, (const bf16_t*)(ws + OFF_W_BOUT), DM, MTOK, DM, DM, 0, e, 0);
      gemm_phase(lds, (const bf16_t*)(ws + S1_AB), DM, (const bf16_t*)(ws + OFF_W_BOUT), DM, MTOK, DM, DM, 0, e, 1); }
    xcd_barrier(xb);
    mlp_block(p, lds, xb, 1);

}

extern "C" void kernel_launch(void* const* d_in, const int* in_sizes, int n_in, void* d_out, int out_size, void* d_ws, size_t ws_size, hipStream_t stream) {
    static int grid_blocks = 0;
    if (grid_blocks == 0) {
        if (n_in != 20 || ws_size < WS_NEED) { fprintf(stderr, "kernel_launch: unexpected n_in %d or ws_size %zu (need %zu)\n", n_in, ws_size, (size_t)WS_NEED); grid_blocks = -1; return; }
        int dev = 0, cus = 0, per_cu = 0;
        (void)hipGetDevice(&dev);
        (void)hipDeviceGetAttribute(&cus, hipDeviceAttributeMultiprocessorCount, dev);
        if (hipFuncSetAttribute((const void*)mega_fwd, hipFuncAttributeMaxDynamicSharedMemorySize, LDS_BYTES) != hipSuccess) { fprintf(stderr, "kernel_launch: hipFuncSetAttribute failed\n"); }
        if (hipOccupancyMaxActiveBlocksPerMultiprocessor(&per_cu, (const void*)mega_fwd, 512, LDS_BYTES) != hipSuccess || per_cu < 1) { fprintf(stderr, "kernel_launch: occupancy query says %d\n", per_cu); per_cu = 1; }
        (void)hipGetLastError();
        grid_blocks = cus * per_cu;
    }
    if (grid_blocks < 0) return;
    (void)hipMemsetAsync((char*)d_ws + OFF_BAR, 0, 16384 + SZ_MOD64 + SZ_CNT, stream);
    Params p{};
    const float** pp = (const float**)&p;
    for (int i = 0; i < 20; ++i) pp[i] = (const float*)d_in[i];
    p.out = (float*)d_out; p.ws = (unsigned char*)d_ws;
    void* args[] = {&p};
    hipError_t e = hipLaunchCooperativeKernel((const void*)mega_fwd, dim3(grid_blocks), dim3(512), args, LDS_BYTES, stream);
    if (e != hipSuccess) fprintf(stderr, "cooperative launch failed: %s (grid %d)\n", hipGetErrorString(e), grid_blocks);
}
```
